# Optimizing an MI355X kernel written in HIP

```python
import math
import jax
import jax.numpy as jnp
from jax import lax
import numpy as np

D_MODEL = 1024
BATCH = 16
SEQ = 2048
DEPTH = 4

CHUNK = 64
CONV_W = 4
D_FF = 4 * D_MODEL
NORM_EPS = 1e-6
L2_EPS = 1e-6
MIX_W = D_MODEL // 2
MIX_OUT = 2 * MIX_W

GDN_HEADS = 4
GDN_DK = MIX_W // GDN_HEADS
GDN_DV = MIX_W // GDN_HEADS
GLA_HEADS = 4
GLA_DK = MIX_W // (2 * GLA_HEADS)
GLA_DV = MIX_W // GLA_HEADS
GLA_GATE_RANK = 16
GLA_TAU = 16.0
GLA_LOG_GATE_MIN = -1.0
SSD_HEADS = 8
SSD_P = MIX_W // SSD_HEADS
SSD_GROUPS = 2
SSD_STATE = 128
RWKV_HEADS = 8
RWKV_DK = MIX_W // RWKV_HEADS
RWKV_W_RANK = 64
RWKV_A_RANK = 64
RWKV_G_RANK = 128
RWKV_GN_EPS = 64e-5

N_EVEN = (DEPTH + 1) // 2
N_ODD = DEPTH // 2

A_QK = GDN_HEADS * GDN_DK
A_V = GDN_HEADS * GDN_DV
A_QKV = 2 * A_QK + A_V
B_QK = GLA_HEADS * GLA_DK
B_V = GLA_HEADS * GLA_DV
EVEN_SPLITS = (A_QKV, A_V, GDN_HEADS, GDN_HEADS, B_QK, B_QK, B_V, B_V, GLA_GATE_RANK)
EVEN_IN = sum(EVEN_SPLITS)

C_X = SSD_HEADS * SSD_P
C_BC = SSD_GROUPS * SSD_STATE
C_XBC = C_X + 2 * C_BC
D_HK = RWKV_HEADS * RWKV_DK
D_SPLITS = (D_HK, D_HK, D_HK, RWKV_W_RANK, RWKV_A_RANK, RWKV_G_RANK)
D_IN = sum(D_SPLITS)
ODD_SPLITS = (C_X, C_XBC, SSD_HEADS, D_IN)
ODD_IN = sum(ODD_SPLITS)

kernel_name = 'hybrid_gdn_gla_ssd_rwkv7_trunk'


def _rmsnorm(x, w):
    xf = x.astype(jnp.float32)
    y = xf * lax.rsqrt(jnp.mean(xf * xf, axis=-1, keepdims=True) + NORM_EPS)
    return (y * w.astype(jnp.float32)).astype(x.dtype)


def _l2norm(x):
    xf = x.astype(jnp.float32)
    return xf * lax.rsqrt(jnp.sum(xf * xf, axis=-1, keepdims=True) + L2_EPS)


def _split(t, sizes):
    parts, off = [], 0
    for s in sizes:
        parts.append(t[..., off:off + s])
        off += s
    return parts


def _causal_dwconv(x, w):
    ch = x.shape[-1]
    return lax.conv_general_dilated(
        x, w[:, None, :].astype(x.dtype), window_strides=(1,),
        padding=[(w.shape[0] - 1, 0)], dimension_numbers=('NWC', 'WIO', 'NWC'),
        feature_group_count=ch)


def _shift(x):
    return jnp.pad(x, ((0, 0), (1, 0), (0, 0)))[:, :-1]


def _to_chunks(t):
    t = t.reshape(t.shape[0], t.shape[1] // CHUNK, CHUNK, *t.shape[2:])
    return jnp.moveaxis(t, 2, 3)


def _from_chunks(t):
    t = jnp.moveaxis(t, 3, 2)
    return t.reshape(t.shape[0], t.shape[1] * t.shape[2], *t.shape[3:])


def _causal_mask(strict=False):
    return jnp.tril(jnp.ones((CHUNK, CHUNK), dtype=bool), -1 if strict else 0)


def _gated_delta_chunked(q, k, v, g, beta):
    bsz, _, nh, dk = q.shape
    dv = v.shape[-1]
    q = _to_chunks(q * dk ** -0.5)
    k = _to_chunks(k)
    v = _to_chunks(v)
    beta = _to_chunks(beta)
    gc = jnp.cumsum(_to_chunks(g), axis=-1)
    dmask = jnp.exp(jnp.where(_causal_mask(), gc[..., :, None] - gc[..., None, :], -jnp.inf))
    kb = k * beta[..., None]
    l_strict = jnp.where(_causal_mask(True), jnp.einsum('bnhik,bnhjk->bnhij', kb, k) * dmask, 0.0)
    eye = jnp.eye(CHUNK, dtype=l_strict.dtype)
    t_inv = lax.linalg.triangular_solve(eye + l_strict, jnp.broadcast_to(eye, l_strict.shape),
                                        left_side=True, lower=True, unit_diagonal=True)
    u = jnp.einsum('bnhij,bnhjv->bnhiv', t_inv, v * beta[..., None])
    w = jnp.einsum('bnhij,bnhjk->bnhik', t_inv, kb * jnp.exp(gc)[..., None])
    a_qk = jnp.einsum('bnhik,bnhjk->bnhij', q, k) * dmask
    qg = q * jnp.exp(gc)[..., None]
    kd = k * jnp.exp(gc[..., -1:] - gc)[..., None]
    g_last = jnp.exp(gc[..., -1])

    def step(state, inp):
        u_n, w_n, qg_n, a_n, kd_n, gl_n = inp
        v_new = u_n - jnp.einsum('bhik,bhkv->bhiv', w_n, state)
        o_n = jnp.einsum('bhik,bhkv->bhiv', qg_n, state) + jnp.einsum('bhij,bhjv->bhiv', a_n, v_new)
        state = state * gl_n[..., None, None] + jnp.einsum('bhik,bhiv->bhkv', kd_n, v_new)
        return state, o_n

    xs = tuple(jnp.moveaxis(t, 1, 0) for t in (u, w, qg, a_qk, kd, g_last))
    _, o = lax.scan(step, jnp.zeros((bsz, nh, dk, dv), q.dtype), xs)
    return _from_chunks(jnp.moveaxis(o, 0, 1))


def _gla_chunked(q, k, v, log_a):
    bsz, _, nh, dk = q.shape
    dv = v.shape[-1]
    gc = jnp.cumsum(_to_chunks(log_a), axis=3)
    q = _to_chunks(q * dk ** -0.5)
    k = _to_chunks(k)
    v = _to_chunks(v)
    qg = q * jnp.exp(gc)
    kg = k * jnp.exp(-gc)
    att = jnp.where(_causal_mask(), jnp.einsum('bnhik,bnhjk->bnhij', qg, kg), 0.0)
    o_intra = jnp.einsum('bnhij,bnhjv->bnhiv', att, v)
    kd = k * jnp.exp(gc[..., -1:, :] - gc)
    g_last = jnp.exp(gc[..., -1, :])

    def step(state, inp):
        kd_n, v_n, gl_n = inp
        new = state * gl_n[..., None] + jnp.einsum('bhik,bhiv->bhkv', kd_n, v_n)
        return new, state

    xs = tuple(jnp.moveaxis(t, 1, 0) for t in (kd, v, g_last))
    _, s_prev = lax.scan(step, jnp.zeros((bsz, nh, dk, dv), q.dtype), xs)
    o_inter = jnp.einsum('bnhik,bnhkv->bnhiv', qg, jnp.moveaxis(s_prev, 0, 1))
    return _from_chunks(o_intra + o_inter)


def _ssd_chunked(x, dt, a_head, b_in, c_in):
    bsz, seq, nh, hp = x.shape
    ng, ns = b_in.shape[2:]
    nr = nh // ng
    nc = seq // CHUNK
    ac = jnp.cumsum((dt * a_head).reshape(bsz, nc, CHUNK, ng, nr), axis=2)
    xdt = (x * dt[..., None]).reshape(bsz, nc, CHUNK, ng, nr, hp)
    bc = b_in.reshape(bsz, nc, CHUNK, ng, ns)
    cc = c_in.reshape(bsz, nc, CHUNK, ng, ns)
    seg = jnp.exp(jnp.where(_causal_mask()[:, :, None, None],
                            ac[:, :, :, None] - ac[:, :, None, :], -jnp.inf))
    cb = jnp.einsum('bcigs,bcjgs->bcijg', cc, bc)
    y_intra = jnp.einsum('bcijgr,bcjgrp->bcigrp', cb[..., None] * seg, xdt)
    st_local = jnp.einsum('bcjgs,bcjgrp->bcgrps', bc, xdt * jnp.exp(ac[:, :, -1:] - ac)[..., None])
    chunk_decay = jnp.exp(ac[:, :, -1])

    def step(state, inp):
        st_n, cd_n = inp
        return state * cd_n[..., None, None] + st_n, state

    _, s_prev = lax.scan(step, jnp.zeros((bsz, ng, nr, hp, ns), x.dtype),
                         (jnp.moveaxis(st_local, 1, 0), jnp.moveaxis(chunk_decay, 1, 0)))
    y_inter = jnp.einsum('bcigs,bcgrps->bcigrp', cc, jnp.moveaxis(s_prev, 0, 1)) * jnp.exp(ac)[..., None]
    return (y_intra + y_inter).reshape(bsz, seq, nh, hp)


def _rwkv7_scan(r, w, k, v, a, b):
    bsz, _, nh, dk = r.shape

    def step(state, inp):
        r_t, w_t, k_t, v_t, a_t, b_t = inp
        sa = jnp.einsum('bhvk,bhk->bhv', state, a_t)
        state = (state * w_t[:, :, None, :] + sa[..., None] * b_t[:, :, None, :]
                 + v_t[..., None] * k_t[:, :, None, :])
        return state, jnp.einsum('bhvk,bhk->bhv', state, r_t)

    xs = tuple(jnp.moveaxis(t, 1, 0) for t in (r, w, k, v, a, b))
    _, ys = lax.scan(step, jnp.zeros((bsz, nh, dk, dk), r.dtype), xs)
    return jnp.moveaxis(ys, 0, 1)


def _even_mixer(h, w_in, conv_w, a_log, dt_bias, gdn_norm_w, gla_w2, gla_b, gla_norm_w, w_out):
    bsz, seq, _ = h.shape
    f32 = jnp.float32
    qkv, z, b_raw, a_raw, gq, gk, gv, gr, g_lr = _split(h @ w_in, EVEN_SPLITS)
    qkv = jax.nn.silu(_causal_dwconv(qkv, conv_w)).astype(f32)
    aq, ak, av = _split(qkv, (A_QK, A_QK, A_V))
    aq = _l2norm(aq.reshape(bsz, seq, GDN_HEADS, GDN_DK))
    ak = _l2norm(ak.reshape(bsz, seq, GDN_HEADS, GDN_DK))
    av = av.reshape(bsz, seq, GDN_HEADS, GDN_DV)
    beta = jax.nn.sigmoid(b_raw.astype(f32))
    g = -jnp.exp(a_log.astype(f32)) * jax.nn.softplus(a_raw.astype(f32) + dt_bias.astype(f32))
    oa = _gated_delta_chunked(aq, ak, av, g, beta)
    oa = _rmsnorm(oa, gdn_norm_w) * jax.nn.silu(z.astype(f32).reshape(bsz, seq, GDN_HEADS, GDN_DV))
    log_a = jnp.maximum(jax.nn.log_sigmoid((g_lr @ gla_w2 + gla_b).astype(f32)) / GLA_TAU,
                        GLA_LOG_GATE_MIN)
    ob = _gla_chunked(gq.astype(f32).reshape(bsz, seq, GLA_HEADS, GLA_DK),
                      gk.astype(f32).reshape(bsz, seq, GLA_HEADS, GLA_DK),
                      gv.astype(f32).reshape(bsz, seq, GLA_HEADS, GLA_DV),
                      log_a.reshape(bsz, seq, GLA_HEADS, GLA_DK))
    ob = _rmsnorm(ob, gla_norm_w) * jax.nn.silu(gr.astype(f32).reshape(bsz, seq, GLA_HEADS, GLA_DV))
    o = jnp.concatenate([oa.reshape(bsz, seq, A_V), ob.reshape(bsz, seq, B_V)], axis=-1)
    return o.astype(h.dtype) @ w_out


def _odd_mixer(h, w_in, conv_w, conv_b, dt_bias, a_log, d_skip, ssd_norm_w, mu, w0, w2, a0, a2, g2,
               k_k, k_a, r_k, gn_w, gn_b, w_out):
    bsz, seq, _ = h.shape
    f32 = jnp.float32
    z, xbc, dt_raw, pd = _split(h @ w_in, ODD_SPLITS)
    xbc = jax.nn.silu(_causal_dwconv(xbc, conv_w) + conv_b).astype(f32)
    xs, b_in, c_in = _split(xbc, (C_X, C_BC, C_BC))
    xs = xs.reshape(bsz, seq, SSD_HEADS, SSD_P)
    dt = jax.nn.softplus(dt_raw.astype(f32) + dt_bias.astype(f32))
    yc = _ssd_chunked(xs, dt, -jnp.exp(a_log.astype(f32)),
                      b_in.reshape(bsz, seq, SSD_GROUPS, SSD_STATE),
                      c_in.reshape(bsz, seq, SSD_GROUPS, SSD_STATE))
    yc = (yc + xs * d_skip.astype(f32)[:, None]).reshape(bsz, seq, C_X) * jax.nn.silu(z.astype(f32))
    yc = _rmsnorm(yc.reshape(bsz, seq, SSD_GROUPS, C_X // SSD_GROUPS),
                  ssd_norm_w.reshape(SSD_GROUPS, C_X // SSD_GROUPS)).reshape(bsz, seq, C_X)
    pd = pd.astype(f32)
    pd = pd + (_shift(pd) - pd) * mu.astype(f32)
    r, k, v, xw, xa, xg = _split(pd, D_SPLITS)
    w_log = -jax.nn.softplus(-(w0 + jnp.tanh(xw) @ w2)) - 0.5
    decay = jnp.exp(-jnp.exp(w_log))
    a = jax.nn.sigmoid(a0 + xa @ a2)
    g = jax.nn.sigmoid(xg) @ g2
    hs = (bsz, seq, RWKV_HEADS, RWKV_DK)
    kk = _l2norm((k * k_k).reshape(hs))
    k = k * (1.0 + (a - 1.0) * k_a)
    r4, k4, v4, a4 = (t.reshape(hs) for t in (r, k, v, a))
    yd = _rwkv7_scan(r4, decay.reshape(hs), k4, v4, -kk, kk * a4)
    mean = jnp.mean(yd, axis=-1, keepdims=True)
    var = jnp.mean(jnp.square(yd - mean), axis=-1, keepdims=True)
    yd = ((yd - mean) * lax.rsqrt(var + RWKV_GN_EPS)).reshape(bsz, seq, D_HK) * gn_w + gn_b
    yd = (yd + (jnp.sum(r4 * k4 * r_k, axis=-1, keepdims=True) * v4).reshape(bsz, seq, D_HK)) * g
    o = jnp.concatenate([yc, yd], axis=-1)
    return o.astype(h.dtype) @ w_out


def _sqrelu_mlp(h, w1, w2):
    return jnp.square(jax.nn.relu(h @ w1)) @ w2


def setup_inputs(seed: int = 0) -> dict:
    key = jax.random.key(seed)
    keys = iter(jax.random.split(key, 48))
    f32 = jnp.float32

    def nrm(shape, scale):
        return jax.random.normal(next(keys), shape, f32) * scale

    def gain(shape):
        return 1.0 + nrm(shape, 0.02)

    def unif(shape, lo, hi):
        return jax.random.uniform(next(keys), shape, f32, lo, hi)

    def dtb(shape):
        dt = jnp.exp(unif(shape, math.log(1e-3), math.log(1e-1)))
        return dt + jnp.log(-jnp.expm1(-dt))

    return {
        'x': nrm((BATCH, SEQ, D_MODEL), 1.0),
        'norm_mix_w': gain((DEPTH, D_MODEL)),
        'norm_mlp_w': gain((DEPTH, D_MODEL)),
        'mlp_w1': nrm((DEPTH, D_MODEL, D_FF), D_MODEL ** -0.5),
        'mlp_w2': nrm((DEPTH, D_FF, D_MODEL), D_FF ** -0.5),
        'final_norm_w': gain((D_MODEL,)),
        'even_w_in': nrm((N_EVEN, D_MODEL, EVEN_IN), D_MODEL ** -0.5),
        'gdn_conv_w': nrm((N_EVEN, CONV_W, A_QKV), CONV_W ** -0.5),
        'gdn_a_log': jnp.log(unif((N_EVEN, GDN_HEADS), 1.0, 16.0)),
        'gdn_dt_bias': dtb((N_EVEN, GDN_HEADS)),
        'gdn_norm_w': gain((N_EVEN, GDN_DV)),
        'gla_gate_w2': nrm((N_EVEN, GLA_GATE_RANK, B_QK), GLA_GATE_RANK ** -0.5),
        'gla_gate_b': nrm((N_EVEN, B_QK), 0.1),
        'gla_norm_w': gain((N_EVEN, GLA_DV)),
        'even_w_out': nrm((N_EVEN, MIX_OUT, D_MODEL), MIX_OUT ** -0.5),
        'odd_w_in': nrm((N_ODD, D_MODEL, ODD_IN), D_MODEL ** -0.5),
        'ssd_conv_w': nrm((N_ODD, CONV_W, C_XBC), CONV_W ** -0.5),
        'ssd_conv_b': nrm((N_ODD, C_XBC), 0.02),
        'ssd_dt_bias': dtb((N_ODD, SSD_HEADS)),
        'ssd_a_log': jnp.log(unif((N_ODD, SSD_HEADS), 1.0, 16.0)),
        'ssd_d': gain((N_ODD, SSD_HEADS)),
        'ssd_norm_w': gain((N_ODD, C_X)),
        'rwkv_mu': unif((N_ODD, D_IN), 0.0, 1.0),
        'rwkv_w0': nrm((N_ODD, D_HK), 0.5),
        'rwkv_w2': nrm((N_ODD, RWKV_W_RANK, D_HK), RWKV_W_RANK ** -0.5),
        'rwkv_a0': nrm((N_ODD, D_HK), 0.1),
        'rwkv_a2': nrm((N_ODD, RWKV_A_RANK, D_HK), RWKV_A_RANK ** -0.5),
        'rwkv_g2': nrm((N_ODD, RWKV_G_RANK, D_HK), RWKV_G_RANK ** -0.5),
        'rwkv_k_k': 0.85 + nrm((N_ODD, D_HK), 0.02),
        'rwkv_k_a': gain((N_ODD, D_HK)),
        'rwkv_r_k': nrm((N_ODD, RWKV_HEADS, RWKV_DK), 0.1),
        'rwkv_gn_w': gain((N_ODD, D_HK)),
        'rwkv_gn_b': nrm((N_ODD, D_HK), 0.02),
        'odd_w_out': nrm((N_ODD, MIX_OUT, D_MODEL), MIX_OUT ** -0.5),
    }


def reference(x, norm_mix_w, norm_mlp_w, mlp_w1, mlp_w2, final_norm_w,
              even_w_in, gdn_conv_w, gdn_a_log, gdn_dt_bias, gdn_norm_w,
              gla_gate_w2, gla_gate_b, gla_norm_w, even_w_out,
              odd_w_in, ssd_conv_w, ssd_conv_b, ssd_dt_bias, ssd_a_log, ssd_d, ssd_norm_w,
              rwkv_mu, rwkv_w0, rwkv_w2, rwkv_a0, rwkv_a2, rwkv_g2, rwkv_k_k, rwkv_k_a,
              rwkv_r_k, rwkv_gn_w, rwkv_gn_b, odd_w_out):
    h = x
    for layer in range(DEPTH):
        i = layer // 2
        hn = _rmsnorm(h, norm_mix_w[layer])
        if layer % 2 == 0:
            mix = _even_mixer(hn, even_w_in[i], gdn_conv_w[i], gdn_a_log[i], gdn_dt_bias[i],
                              gdn_norm_w[i], gla_gate_w2[i], gla_gate_b[i], gla_norm_w[i],
                              even_w_out[i])
        else:
            mix = _odd_mixer(hn, odd_w_in[i], ssd_conv_w[i], ssd_conv_b[i], ssd_dt_bias[i],
                             ssd_a_log[i], ssd_d[i], ssd_norm_w[i], rwkv_mu[i], rwkv_w0[i],
                             rwkv_w2[i], rwkv_a0[i], rwkv_a2[i], rwkv_g2[i], rwkv_k_k[i],
                             rwkv_k_a[i], rwkv_r_k[i], rwkv_gn_w[i], rwkv_gn_b[i], odd_w_out[i])
        h = h + mix.astype(h.dtype)
        h = h + _sqrelu_mlp(_rmsnorm(h, norm_mlp_w[layer]), mlp_w1[layer], mlp_w2[layer]).astype(h.dtype)
    return _rmsnorm(h, final_norm_w)
```

```cpp
#include <hip/hip_runtime.h>
#include <hip/hip_cooperative_groups.h>
#include <cstdio>
#include <cstdint>
namespace cg = cooperative_groups;
#ifndef MK_COOP
#define MK_COOP 1
#endif
namespace pg8 {
#define PG8_LAS __attribute__((address_space(3)))
typedef unsigned short bf16_t;
typedef short bf16x8 __attribute__((ext_vector_type(8)));
typedef float f32x4 __attribute__((ext_vector_type(4)));
typedef unsigned u32x4 __attribute__((ext_vector_type(4)));
constexpr int BM = 256, BK = 64, HALF = 128, HTB = HALF * BK * 2  , STAGE_BYTES = 8 * HTB, NXCD = 8, WGM = 8;

__host__ __device__ __forceinline__ int lds_byte(int r, int c) { const int st = (r >> 4) * 2 + (c >> 5), rr = r & 15, cc = c & 31, ob = rr * 64 + cc * 2; return st * 1024 + (ob ^ (((ob >> 9) & 1) << 5)); }
__host__ __device__ __forceinline__ void stage_rc(int b, int& R, int& C) { const int st = b / 1024, sb = b % 1024, swz = sb ^ (((sb >> 9) & 1) << 5); R = (st >> 1) * 16 + swz / 64; C = (st & 1) * 32 + (swz % 64) / 2; }
__host__ __device__ __forceinline__ int perm32(int rho) { const int n = rho >> 4, i = rho & 15; return 8 * (i >> 2) + 4 * n + (i & 3); }

struct Unit { int pm, pn; };
struct Gemm { const bf16_t* A; const bf16_t* Bt; int M, N, K; };

struct StaticOrder {
    int nM, nN, nwg, G, c;
    __host__ __device__ void init(int M, int N, int G_, int c_) { nM = M / BM; nN = N / BM; nwg = nM * nN; G = G_; c = c_; }
    __host__ __device__ bool next(int i, Unit& u) const {
        const long L = (long)i * G + c; if (L >= nwg) return false;
        int wgid = (int)L; { const int q = nwg / NXCD, r = nwg % NXCD, xcd = wgid % NXCD, off = wgid / NXCD; wgid = (xcd < r ? xcd * (q + 1) : r * (q + 1) + (xcd - r) * q) + off; }
        const int nig = WGM * nN, gid = wgid / nig, fm = gid * WGM, gsz = (nM - fm) < WGM ? (nM - fm) : WGM;
        u.pm = fm + ((wgid % nig) % gsz); u.pn = (wgid % nig) / gsz; return true;
    }
    __device__ __forceinline__ void a_ready(const Unit&) const {}
    __device__ __forceinline__ void done(const Unit&) const {}
};

__device__ __forceinline__ unsigned cvt_pk_bf16(float lo, float hi) { unsigned r; asm volatile("v_cvt_pk_bf16_f32 %0, %1, %2" : "=v"(r) : "v"(lo), "v"(hi)); return r; }
__device__ __forceinline__ void rstd_table(const float* ssq, int pm, PG8_LAS float* tab) {
    int t = threadIdx.x; asm volatile("" : "+v"(t));
    const f32x4* p = (const f32x4*)(ssq + ((size_t)pm * BM + (t >> 1)) * 16 + (t & 1) * 8); const f32x4 a = p[0] + p[1];
    float s = (a.x + a.y) + (a.z + a.w);
    s += __builtin_bit_cast(float, __builtin_amdgcn_mov_dpp(__builtin_bit_cast(int, s), 0xB1, 0xf, 0xf, true));
    if ((t & 1) == 0) tab[t >> 1] = __builtin_amdgcn_rsqf(s * (1.f / 1024.f) + 1e-6f);
    asm volatile("s_waitcnt lgkmcnt(0)" ::: "memory"); __builtin_amdgcn_s_barrier(); asm volatile("" ::: "memory");
}
struct EpiProj {
    static constexpr bool PERM = true, AFTER_DRAIN = false;
    bf16_t* O; int ldc; int n_main; float* small; const float* ssq; PG8_LAS float* tab;
    __device__ __forceinline__ void operator()(const f32x4 (&acc)[2][2][4][2], const Unit& u, int wr, int wc, int fr, int fq) const {
        rstd_table(ssq, u.pm, tab);
        const int row0 = u.pm * BM + wr * 64 + fr;
        if (u.pn < n_main) {
            const int col0 = u.pn * BM + wc * 32 + 8 * fq;
#pragma unroll
            for (int ai = 0; ai < 2; ++ai)
#pragma unroll
                for (int m = 0; m < 4; ++m) { bf16_t* rowp = O + (size_t)(row0 + ai * HALF + m * 16) * ldc + col0; const float rs = tab[wr * 64 + fr + ai * HALF + m * 16];
#pragma unroll
                    for (int bj = 0; bj < 2; ++bj) { const f32x4 v0 = acc[ai][bj][m][0] * rs, v1 = acc[ai][bj][m][1] * rs;
                        u32x4 w; w.x = cvt_pk_bf16(v0[0], v0[1]); w.y = cvt_pk_bf16(v0[2], v0[3]); w.z = cvt_pk_bf16(v1[0], v1[1]); w.w = cvt_pk_bf16(v1[2], v1[3]);
                        *(u32x4*)(rowp + bj * HALF) = w; } }
        } else if (wc == 0) {
#pragma unroll
            for (int ai = 0; ai < 2; ++ai)
#pragma unroll
                for (int m = 0; m < 4; ++m) { float* rp = small + (size_t)(row0 + ai * HALF + m * 16) * 32 + 8 * fq; const float rs = tab[wr * 64 + fr + ai * HALF + m * 16];
                    *(f32x4*)rp = acc[ai][0][m][0] * rs; *(f32x4*)(rp + 4) = acc[ai][0][m][1] * rs; }
        }
    }
};
struct EpiSq {
    static constexpr bool PERM = true, AFTER_DRAIN = false;
    bf16_t* O; int ldc; const float* ssq; PG8_LAS float* tab;
    __device__ __forceinline__ void operator()(const f32x4 (&acc)[2][2][4][2], const Unit& u, int wr, int wc, int fr, int fq) const {
        rstd_table(ssq, u.pm, tab);
        const int row0 = u.pm * BM + wr * 64 + fr, col0 = u.pn * BM + wc * 32 + 8 * fq;
#pragma unroll
        for (int ai = 0; ai < 2; ++ai)
#pragma unroll
            for (int m = 0; m < 4; ++m) { bf16_t* rowp = O + (size_t)(row0 + ai * HALF + m * 16) * ldc + col0; const float rs = tab[wr * 64 + fr + ai * HALF + m * 16];
#pragma unroll
                for (int bj = 0; bj < 2; ++bj) { f32x4 v0 = acc[ai][bj][m][0] * rs, v1 = acc[ai][bj][m][1] * rs;
#pragma unroll
                    for (int j = 0; j < 4; ++j) { const float a = fmaxf(v0[j], 0.f), b = fmaxf(v1[j], 0.f); v0[j] = a * a; v1[j] = b * b; }
                    u32x4 w; w.x = cvt_pk_bf16(v0[0], v0[1]); w.y = cvt_pk_bf16(v0[2], v0[3]); w.z = cvt_pk_bf16(v1[0], v1[1]); w.w = cvt_pk_bf16(v1[2], v1[3]);
                    *(u32x4*)(rowp + bj * HALF) = w; } }
    }
};
struct EpiRes {
    static constexpr bool PERM = false, AFTER_DRAIN = false;
    const float* base; float* out; int ldc; bf16_t* hn; float* ssq;
    __device__ __forceinline__ void operator()(const f32x4 (&acc)[2][2][4][2], const Unit& u, int wr, int wc, int fr, int fq) const {
        const int row0 = u.pm * BM + wr * 64 + fr, col0 = u.pn * BM + wc * 32 + 4 * fq;
#pragma unroll
        for (int ai = 0; ai < 2; ++ai)
#pragma unroll
            for (int m = 0; m < 4; ++m) { const int row = row0 + ai * HALF + m * 16; const size_t off = (size_t)row * ldc + col0; float s = 0.f;
#pragma unroll
                for (int bj = 0; bj < 2; ++bj)
#pragma unroll
                    for (int n = 0; n < 2; ++n) { const f32x4 b = *(const f32x4*)(base + off + bj * HALF + n * 16); const f32x4 v = b + acc[ai][bj][m][n]; *(f32x4*)(out + off + bj * HALF + n * 16) = v;
                        s += (v[0] * v[0] + v[1] * v[1]) + (v[2] * v[2] + v[3] * v[3]);
                        typedef unsigned u32x2e __attribute__((ext_vector_type(2)));
                        *(u32x2e*)(hn + off + bj * HALF + n * 16) = (u32x2e){cvt_pk_bf16(v[0], v[1]), cvt_pk_bf16(v[2], v[3])}; }
                { const int ln = fq * 16 + fr;
                  s += __builtin_bit_cast(float, __builtin_amdgcn_ds_bpermute((ln ^ 16) << 2, __builtin_bit_cast(int, s))); s += __builtin_bit_cast(float, __builtin_amdgcn_ds_bpermute((ln ^ 32) << 2, __builtin_bit_cast(int, s))); }
                if (fq == 0) ssq[(size_t)row * 16 + u.pn * 4 + wc] = s; }
    }
};

template <class Epi, class Sched, bool ALIGN_EPI = false, bool SP2 = false>
__device__ __forceinline__ void gemm_phase(PG8_LAS unsigned char* lds, const Gemm g, const Sched& S, const Epi& E) {
    int tid_o = threadIdx.x; asm volatile("" : "+v"(tid_o));
    int K_o = g.K; asm volatile("" : "+s"(K_o));
    const int tid = tid_o, wid = __builtin_amdgcn_readfirstlane(tid >> 6), lane = tid & 63, wr = wid >> 2, wc = wid & 3, fr = lane & 15, fq = lane >> 4;
    const int K = K_o, nt = K / BK;
    unsigned voffA[2], voffB[2];
#pragma unroll
    for (int i = 0; i < 2; ++i) { int R, C; stage_rc(tid * 16 + i * 8192, R, C); const int Rb = Epi::PERM ? ((R & ~31) + perm32(R & 31)) : R;
        voffA[i] = (unsigned)(R * K + C) * 2u; voffB[i] = (unsigned)(Rb * K + C) * 2u; }
    const size_t kstep = (size_t)(BK * 2);
    const size_t hstep = (size_t)HALF * K * 2;
    const size_t tstep = 2 * hstep;
    const unsigned ldsw = (unsigned)wid * 1024u;
    const int aoff = lds_byte(wr * 64 + fr, fq * 8), boff = lds_byte(wc * 32 + fr, fq * 8);
#define PG8_SA(b, h) (((b) * 2 + (h)) * HTB)
#define PG8_SB(b, h) ((4 + (b) * 2 + (h)) * HTB)
#define PG8_STAGE(bufoff, gbase, voff) do { _Pragma("unroll") for (int _i = 0; _i < 2; ++_i) \
        __builtin_amdgcn_global_load_lds((const unsigned*)((const char*)(gbase) + (voff)[_i]), (PG8_LAS unsigned*)(lds + (bufoff) + ldsw + _i * 8192), 16, 0, 0); } while (0)
#define PG8_LDA(dst, b, h) do { _Pragma("unroll") for (int m = 0; m < 4; ++m) _Pragma("unroll") for (int k = 0; k < 2; ++k) dst[m][k] = *(const PG8_LAS bf16x8*)(lds + PG8_SA(b, h) + aoff + m * 2048 + k * 1024); } while (0)
#define PG8_LDB(dst, b, h) do { _Pragma("unroll") for (int n = 0; n < 2; ++n) _Pragma("unroll") for (int k = 0; k < 2; ++k) dst[n][k] = *(const PG8_LAS bf16x8*)(lds + PG8_SB(b, h) + boff + n * 2048 + k * 1024); } while (0)
#define PG8_MMA(ai, bj, At, Bt) do { __builtin_amdgcn_s_setprio(1); _Pragma("unroll") for (int m = 0; m < 4; ++m) _Pragma("unroll") for (int n = 0; n < 2; ++n) _Pragma("unroll") for (int k = 0; k < 2; ++k) \
        acc[ai][bj][m][n] = __builtin_amdgcn_mfma_f32_16x16x32_bf16(Bt[n][k], At[m][k], acc[ai][bj][m][n], 0, 0, 0); __builtin_amdgcn_s_setprio(0); } while (0)
#define PG8_WAIT_V(n) asm volatile("s_waitcnt vmcnt(" #n ")" ::: "memory")
#define PG8_WAIT_L(n) asm volatile("s_waitcnt lgkmcnt(" #n ")" ::: "memory")
#define PG8_BAR __builtin_amdgcn_s_barrier()
#define PG8_SCHED __builtin_amdgcn_sched_barrier(0)
    Unit cur, nxt; int ui = 0;
    if (!S.next(0, cur)) return;
    f32x4 acc[2][2][4][2];
#pragma unroll
    for (int a = 0; a < 2; ++a)
#pragma unroll
        for (int b = 0; b < 2; ++b)
#pragma unroll
            for (int m = 0; m < 4; ++m)
#pragma unroll
                for (int n = 0; n < 2; ++n) acc[a][b][m][n] = (f32x4){0.f, 0.f, 0.f, 0.f};
    bf16x8 At[4][2], B0[2][2], B1[2][2];
    const char* cA = (const char*)g.A + (size_t)cur.pm * tstep; const char* cB = (const char*)g.Bt + (size_t)cur.pn * tstep;
    S.a_ready(cur);
    if constexpr (SP2) {
        PG8_STAGE(PG8_SB(0, 0), cB, voffB); PG8_STAGE(PG8_SB(0, 1), cB + hstep, voffB); PG8_STAGE(PG8_SA(0, 0), cA, voffA); PG8_STAGE(PG8_SA(0, 1), cA + hstep, voffA);
        if (wr == 1) PG8_BAR;
        PG8_WAIT_V(2); PG8_BAR;
        PG8_STAGE(PG8_SB(1, 0), cB + kstep, voffB); PG8_STAGE(PG8_SA(1, 0), cA + kstep, voffA); PG8_STAGE(PG8_SB(1, 1), cB + hstep + kstep, voffB);
        PG8_WAIT_V(6); PG8_BAR;
    } else {
        PG8_STAGE(PG8_SB(0, 0), cB, voffB); PG8_STAGE(PG8_SA(0, 0), cA, voffA); PG8_STAGE(PG8_SB(0, 1), cB + hstep, voffB); PG8_STAGE(PG8_SA(0, 1), cA + hstep, voffA);
        if (wr == 1) PG8_BAR;
        PG8_WAIT_V(4); PG8_BAR;
        PG8_STAGE(PG8_SB(1, 0), cB + kstep, voffB); PG8_STAGE(PG8_SA(1, 0), cA + kstep, voffA); PG8_STAGE(PG8_SB(1, 1), cB + hstep + kstep, voffB);
        PG8_WAIT_V(6); PG8_BAR;
    }
    for (;;) {
        const bool has_next = S.next(ui + 1, nxt);
        const char* nA = has_next ? (const char*)g.A + (size_t)nxt.pm * tstep : cA; const char* nB = has_next ? (const char*)g.Bt + (size_t)nxt.pn * tstep : cB;
        for (int t = 0; t < nt; t += 2) {
            const bool last = (t == nt - 2);
            const char* a1 = cA + (size_t)(t + 1) * kstep;
            const char* a2 = last ? nA : cA + (size_t)(t + 2) * kstep; const char* b2 = last ? nB : cB + (size_t)(t + 2) * kstep;
            const char* a3 = a2 + kstep; const char* b3 = b2 + kstep;
            if (last && has_next) S.a_ready(nxt);
            if constexpr (SP2) {
            PG8_LDB(B0, 0, 0); PG8_LDB(B1, 0, 1); PG8_SCHED; PG8_LDA(At, 0, 0); PG8_STAGE(PG8_SA(1, 1), a1 + hstep, voffA);
            PG8_WAIT_V(8); PG8_WAIT_L(0); PG8_BAR; PG8_MMA(0, 0, At, B0); PG8_MMA(0, 1, At, B1); PG8_BAR; PG8_SCHED;
            PG8_LDA(At, 0, 1); PG8_STAGE(PG8_SB(0, 0), b2, voffB); PG8_STAGE(PG8_SB(0, 1), b2 + hstep, voffB); PG8_STAGE(PG8_SA(0, 0), a2, voffA);
            PG8_WAIT_V(8); PG8_WAIT_L(0); PG8_BAR; PG8_MMA(1, 0, At, B0); PG8_MMA(1, 1, At, B1); PG8_BAR; PG8_SCHED;
            PG8_LDB(B0, 1, 0); PG8_LDB(B1, 1, 1); PG8_SCHED; PG8_LDA(At, 1, 0); PG8_STAGE(PG8_SA(0, 1), a2 + hstep, voffA);
            PG8_WAIT_V(8); PG8_WAIT_L(0); PG8_BAR; PG8_MMA(0, 0, At, B0); PG8_MMA(0, 1, At, B1); PG8_BAR; PG8_SCHED;
            PG8_LDA(At, 1, 1); PG8_STAGE(PG8_SB(1, 0), b3, voffB); PG8_STAGE(PG8_SB(1, 1), b3 + hstep, voffB); PG8_STAGE(PG8_SA(1, 0), a3, voffA);
            PG8_WAIT_V(8); PG8_WAIT_L(0); PG8_BAR; PG8_MMA(1, 0, At, B0); PG8_MMA(1, 1, At, B1); PG8_BAR; PG8_SCHED;
            } else {
            PG8_LDB(B0, 0, 0); PG8_SCHED; PG8_LDA(At, 0, 0); PG8_STAGE(PG8_SA(1, 1), a1 + hstep, voffA);
            PG8_WAIT_L(8); PG8_BAR; PG8_WAIT_L(0); PG8_MMA(0, 0, At, B0); PG8_BAR; PG8_SCHED;
            PG8_LDB(B1, 0, 1); PG8_STAGE(PG8_SB(0, 0), b2, voffB);
            PG8_BAR; PG8_WAIT_L(0); PG8_MMA(0, 1, At, B1); PG8_BAR;
            PG8_LDA(At, 0, 1); PG8_STAGE(PG8_SA(0, 0), a2, voffA);
            PG8_BAR; PG8_WAIT_L(0); PG8_MMA(1, 0, At, B0); PG8_BAR; PG8_SCHED;
            PG8_STAGE(PG8_SB(0, 1), b2 + hstep, voffB);
            PG8_WAIT_V(6); PG8_BAR; PG8_MMA(1, 1, At, B1); PG8_BAR;
            PG8_LDB(B0, 1, 0); PG8_SCHED; PG8_LDA(At, 1, 0); PG8_STAGE(PG8_SA(0, 1), a2 + hstep, voffA);
            PG8_WAIT_L(8); PG8_BAR; PG8_WAIT_L(0); PG8_MMA(0, 0, At, B0); PG8_BAR; PG8_SCHED;
            PG8_LDB(B1, 1, 1); PG8_STAGE(PG8_SB(1, 0), b3, voffB);
            PG8_BAR; PG8_WAIT_L(0); PG8_MMA(0, 1, At, B1); PG8_BAR;
            PG8_LDA(At, 1, 1); PG8_STAGE(PG8_SA(1, 0), a3, voffA);
            PG8_BAR; PG8_WAIT_L(0); PG8_MMA(1, 0, At, B0); PG8_BAR; PG8_SCHED;
            PG8_STAGE(PG8_SB(1, 1), b3 + hstep, voffB);
            PG8_WAIT_V(6); PG8_BAR; PG8_MMA(1, 1, At, B1); PG8_BAR;
            }
        }
        if constexpr (ALIGN_EPI) { if (wr == 0) PG8_BAR; }
        if constexpr (!Epi::AFTER_DRAIN) { E(acc, cur, wr, wc, fr, fq); S.done(cur); }
        if (!has_next) break;
#pragma unroll
        for (int a = 0; a < 2; ++a)
#pragma unroll
            for (int b = 0; b < 2; ++b)
#pragma unroll
                for (int m = 0; m < 4; ++m)
#pragma unroll
                    for (int n = 0; n < 2; ++n) acc[a][b][m][n] = (f32x4){0.f, 0.f, 0.f, 0.f};
        cur = nxt; cA = nA; cB = nB; ++ui;
        if constexpr (ALIGN_EPI) { if (wr == 1) PG8_BAR; }
    }
    PG8_WAIT_V(0);
    if constexpr (!ALIGN_EPI) { if (wr == 0) PG8_BAR; }
    PG8_BAR;
    if constexpr (Epi::AFTER_DRAIN) { E.fused(acc, cur, wr, wc, fr, fq, lds, wid, lane); S.done(cur); }
#undef PG8_SA
#undef PG8_SB
#undef PG8_STAGE
#undef PG8_LDA
#undef PG8_LDB
#undef PG8_MMA
#undef PG8_WAIT_V
#undef PG8_WAIT_L
#undef PG8_BAR
#undef PG8_SCHED
}
}
#define GAS __attribute__((address_space(1)))
#define LAS __attribute__((address_space(3)))
typedef unsigned short bf16;
typedef unsigned v4u __attribute__((ext_vector_type(4)));
typedef float f32x4 __attribute__((ext_vector_type(4)));
typedef float f32x2 __attribute__((ext_vector_type(2)));
typedef short bf16x8_t __attribute__((ext_vector_type(8)));
constexpr int NWAVES = 8, NT = 512;
constexpr int M = 32768, D = 1024, SEQ = 2048, NBATCH = 16, FF = 4096, DEPTH = 4;
constexpr int EVEN_IN = 3608, ODD_IN = 3336, NE = 3840, NO = 3584, PE = 3584, PO = 3328;
constexpr size_t MiB = 1u << 20;
constexpr size_t WS_W = 2 * MiB, W_LAYER = 10 * MiB, W_IN = 0, W_OUT = 8 * MiB, WS_WMLP = 42 * MiB, W_1 = 0, W_2 = 8 * MiB;
constexpr size_t WS_SSQ = 126 * MiB, WS_HN = 448 * MiB, WS_RS = 336 * MiB;
constexpr size_t WS_XN = 58 * MiB, WS_SMALL = 122 * MiB, WS_PROJ = 128 * MiB, WS_GS = 352 * MiB, WS_END = 512 * MiB;
constexpr int LDS_BYTES = 147456, MISC_OFF = 147456 - 256, RSTD_OFF = 131072;
constexpr size_t WS_CTL = 0, CTL_ZERO_BYTES = 65536; constexpr int CW_BAR = 4096;
constexpr float NORM_EPS = 1e-6f, L2_EPS = 1e-6f;

#define LDS_WAIT() asm volatile("s_waitcnt lgkmcnt(0)" ::: "memory")
#define LDS_BARRIER() do { asm volatile("s_waitcnt lgkmcnt(0)" ::: "memory"); __builtin_amdgcn_s_barrier(); asm volatile("" ::: "memory"); } while (0)
typedef __bf16 hwbf16x2_t __attribute__((ext_vector_type(2)));
__device__ __forceinline__ unsigned pk2(float lo, float hi) { const f32x2 v = {lo, hi}; return __builtin_bit_cast(unsigned, __builtin_convertvector(v, hwbf16x2_t)); }
__device__ __forceinline__ unsigned f2bf(float f) { return pk2(f, 0.f) & 0xffffu; }
__device__ __forceinline__ float bflo(unsigned u) { return __builtin_bit_cast(float, u << 16); }
__device__ __forceinline__ float bfhi(unsigned u) { return __builtin_bit_cast(float, u & 0xffff0000u); }
template <int CTRL, int RMASK, bool BC> __device__ __forceinline__ float dpp_add(float v) { return v + __builtin_bit_cast(float, __builtin_amdgcn_update_dpp(0, __builtin_bit_cast(int, v), CTRL, RMASK, 0xf, BC)); }
__device__ __forceinline__ float wave_sum(float v) {
    v = dpp_add<0x111, 0xf, true>(v); v = dpp_add<0x112, 0xf, true>(v); v = dpp_add<0x114, 0xf, true>(v); v = dpp_add<0x118, 0xf, true>(v);
    v = dpp_add<0x142, 0xa, false>(v); v = dpp_add<0x143, 0xc, false>(v);
    return __builtin_bit_cast(float, __builtin_amdgcn_readlane(__builtin_bit_cast(int, v), 63));
}
__device__ __forceinline__ float half_sum(float v, int lane) {
    v = dpp_add<0x111, 0xf, true>(v); v = dpp_add<0x112, 0xf, true>(v); v = dpp_add<0x114, 0xf, true>(v); v = dpp_add<0x118, 0xf, true>(v);
    v = dpp_add<0x142, 0xa, false>(v);
    const float lo = __builtin_bit_cast(float, __builtin_amdgcn_readlane(__builtin_bit_cast(int, v), 31)), hi = __builtin_bit_cast(float, __builtin_amdgcn_readlane(__builtin_bit_cast(int, v), 63));
    return lane < 32 ? lo : hi;
}
__device__ __forceinline__ float ftanh(float x) { return 1.f - 2.f * __builtin_amdgcn_rcpf(1.f + __expf(2.f * x)); }
template <int CTRL> __device__ __forceinline__ float dppf(float x) { return __builtin_bit_cast(float, __builtin_amdgcn_mov_dpp(__builtin_bit_cast(int, x), CTRL, 0xf, 0xf, true)); }
__device__ __forceinline__ float red4(float v) { v += dppf<0xB1>(v); v += dppf<0x4E>(v); return v; }
__device__ __forceinline__ float red8(float v) { v = red4(v); v += dppf<0x141>(v); return v; }
__device__ __forceinline__ float red16(float v) { v = red8(v); v += dppf<0x140>(v); return v; }
__device__ __forceinline__ float frcp(float x) { return __builtin_amdgcn_rcpf(x); }
__device__ __forceinline__ float frsq(float x) { return __builtin_amdgcn_rsqf(x); }
__device__ __forceinline__ float sigm(float x) { return frcp(1.f + __expf(-x)); }
__device__ __forceinline__ float silu(float x) { return x * frcp(1.f + __expf(-x)); }
__device__ __forceinline__ f32x2 silu2(f32x2 x) { const f32x2 a = x * -1.4426950408889634f; f32x2 e; e.x = __builtin_amdgcn_exp2f(a.x); e.y = __builtin_amdgcn_exp2f(a.y); e = e + 1.f; f32x2 r; r.x = __builtin_amdgcn_rcpf(e.x); r.y = __builtin_amdgcn_rcpf(e.y); return x * r; }
__device__ __forceinline__ float softplus(float x) { return fmaxf(x, 0.f) + __logf(1.f + __expf(-fabsf(x))); }

__device__ __forceinline__ void transpose_item(const float* W, int Nsrc, int K, bf16* WT, int n0, int s0, int k0, LAS float* scr, int lane, const float* ks) {
#pragma unroll 8
    for (int i = 0; i < 32; ++i) { const int kk = 2 * i + (lane >> 5); scr[kk * 33 + (lane & 31)] = W[(size_t)(k0 + kk) * Nsrc + s0 + (lane & 31)] * (ks ? ks[k0 + kk] : 1.f); }
    LDS_WAIT(); asm volatile("" ::: "memory");
    const int c = lane & 7;
#pragma unroll
    for (int j = 0; j < 4; ++j) { const int n = (lane >> 3) + 8 * j; const LAS float* s = scr + (8 * c) * 33 + n;
        v4u o; o.x = pk2(s[0 * 33], s[1 * 33]); o.y = pk2(s[2 * 33], s[3 * 33]); o.z = pk2(s[4 * 33], s[5 * 33]); o.w = pk2(s[6 * 33], s[7 * 33]);
        *(v4u*)(WT + (size_t)(n0 + n) * K + k0 + 8 * c) = o; }
    LDS_WAIT(); asm volatile("" ::: "memory");
}
__device__ __forceinline__ void transpose_matrix(const float* W, int Nsrc, int K, bf16* WT, int Nmain, int split, LAS float* scr, int gw, int NGW, int lane, const float* ks) {
    const int nblk = Nmain / 32, items = (K / 64) * nblk;
    for (int it = gw; it < items; it += NGW) { const int kb = it / nblk, nb = it % nblk, n0 = nb * 32; transpose_item(W, Nsrc, K, WT, n0, n0 < split ? n0 : n0 + 8, kb * 64, scr, lane, ks); }
}
__device__ __forceinline__ void tail_rows(const float* W, int Nsrc, bf16* WT, int Nmain, int Npad, bool even, int gt, int NGT, const float* ks) {
    const int total = (Npad - Nmain) * D;
    for (int e = gt; e < total; e += NGT) { const int r = e / D, k = e % D; int src = -1;
        if (even) { if (r < 8) src = 2048 + r; else if (r < 24) src = 3592 + (r - 8); } else { if (r < 8) src = 1536 + r; }
        WT[(size_t)(Nmain + r) * D + k] = src >= 0 ? (bf16)f2bf(W[(size_t)k * Nsrc + src] * ks[k]) : (bf16)0; }
}
__device__ __forceinline__ void norm_rows_bf16(const float* src, const float* w, bf16* dst, int gw, int NGW, int lane) {
    f32x4 wv[4];
#pragma unroll
    for (int j = 0; j < 4; ++j) wv[j] = *((const f32x4*)w + lane + 64 * j);
    for (int m = gw; m < M; m += NGW) {
        const f32x4* xr = (const f32x4*)(src + (size_t)m * D) + lane;
        f32x4 v[4]; float s = 0.f;
#pragma unroll
        for (int j = 0; j < 4; ++j) { v[j] = xr[64 * j]; s += (v[j].x * v[j].x + v[j].y * v[j].y) + (v[j].z * v[j].z + v[j].w * v[j].w); }
        const float rstd = frsq(wave_sum(s) * (1.f / D) + NORM_EPS);
        unsigned long long* o8 = (unsigned long long*)(dst + (size_t)m * D) + lane;
#pragma unroll
        for (int j = 0; j < 4; ++j) { const f32x4 y = v[j] * rstd * wv[j]; o8[64 * j] = (unsigned long long)pk2(y.x, y.y) | ((unsigned long long)pk2(y.z, y.w) << 32); }
    }
}
__device__ __forceinline__ void copy_rows_bf16_ssq(const float* src, bf16* dst, float* ssq, int gw, int NGW, int lane) {
    for (int m = gw; m < M; m += NGW) {
        const f32x4* xr = (const f32x4*)(src + (size_t)m * D) + lane;
        f32x4 v[4]; float s = 0.f;
#pragma unroll
        for (int j = 0; j < 4; ++j) { v[j] = xr[64 * j]; s += (v[j].x * v[j].x + v[j].y * v[j].y) + (v[j].z * v[j].z + v[j].w * v[j].w); }
        s = wave_sum(s);
        unsigned long long* o8 = (unsigned long long*)(dst + (size_t)m * D) + lane;
#pragma unroll
        for (int j = 0; j < 4; ++j) o8[64 * j] = (unsigned long long)pk2(v[j].x, v[j].y) | ((unsigned long long)pk2(v[j].z, v[j].w) << 32);
        if (lane < 16) ssq[(size_t)m * 16 + lane] = lane == 0 ? s : 0.f;
    }
}
__device__ __forceinline__ void norm_rows_f32(float* io, const float* w, int gw, int NGW, int lane) {
    f32x4 wv[4];
#pragma unroll
    for (int j = 0; j < 4; ++j) wv[j] = *((const f32x4*)w + lane + 64 * j);
    for (int m = gw; m < M; m += NGW) {
        f32x4* xr = (f32x4*)(io + (size_t)m * D) + lane;
        f32x4 v[4]; float s = 0.f;
#pragma unroll
        for (int j = 0; j < 4; ++j) { v[j] = xr[64 * j]; s += (v[j].x * v[j].x + v[j].y * v[j].y) + (v[j].z * v[j].z + v[j].w * v[j].w); }
        const float rstd = frsq(wave_sum(s) * (1.f / D) + NORM_EPS);
#pragma unroll
        for (int j = 0; j < 4; ++j) xr[64 * j] = v[j] * rstd * wv[j];
    }
}
#define XB_TMO      128
#define XB_XCNT(j)  (256  + 64 * (j))
#define XB_XSUB(j)  (1280 + 64 * (j))
#define XB_XGEN(j)  (2304 + 64 * (j))
#define XB_TOP      3328
#define XB_TOPGEN   3392
#define XCD_BAR_WORDS 3456
#define XB_SPIN_CAP (1u << 18)

__device__ __forceinline__ unsigned xb_ld(unsigned* p)              { return __hip_atomic_load(p, __ATOMIC_RELAXED, __HIP_MEMORY_SCOPE_AGENT); }
__device__ __forceinline__ unsigned xb_add(unsigned* p, unsigned v) { return __hip_atomic_fetch_add(p, v, __ATOMIC_RELAXED, __HIP_MEMORY_SCOPE_AGENT); }
__device__ __forceinline__ unsigned xb_xcc_id() { return (unsigned)__builtin_amdgcn_s_getreg((3 << 11) | 20) & 0xFu; }
#define XB_SPIN(cond, bar) do { unsigned _sp = 0; while (cond) { __builtin_amdgcn_s_sleep(1); \
    if ((++_sp & 255u) == 0u) { if (xb_ld(&(bar)[XB_TMO])) break; if (_sp > XB_SPIN_CAP) { atomicAdd(&(bar)[XB_TMO], 1u); break; } } } } while (0)

struct XcdBarrier {
    unsigned* bar; unsigned x;
    volatile LAS unsigned* st;
};

__device__ __forceinline__ XcdBarrier xcd_barrier_post(unsigned* bar, volatile LAS unsigned* st) {
    XcdBarrier b; b.bar = bar; b.x = xb_xcc_id(); b.st = st;
    if (threadIdx.x == 0) (void)xb_add(&bar[XB_XCNT(b.x)], 1u);
    return b;
}
__device__ __forceinline__ void xcd_barrier_complete(unsigned* bar, unsigned x, unsigned& nloc, unsigned& nx) {
    const unsigned G = gridDim.x * gridDim.y * gridDim.z;
    unsigned sum, cnt, mine, sp = 0u;
    for (;;) {
        sum = 0u; cnt = 0u; mine = 0u;
#pragma unroll
        for (unsigned j = 0; j < 16; ++j) { const unsigned c = xb_ld(&bar[XB_XCNT(j)]); sum += c; cnt += (c > 0u) ? 1u : 0u; mine = (j == x) ? c : mine; }
        if (sum == G) break;
        __builtin_amdgcn_s_sleep(1);
        if ((++sp & 255u) == 0u) { if (xb_ld(&bar[XB_TMO])) break; if (sp > XB_SPIN_CAP) { atomicAdd(&bar[XB_TMO], 1u); break; } }
    }
    nloc = mine > 0u ? mine : 1u; nx = cnt > 0u ? cnt : 1u;
}

__device__ __forceinline__ void xcd_barrier(const XcdBarrier& b) {
    asm volatile("s_waitcnt vmcnt(0)" ::: "memory");
    __syncthreads();
    if (threadIdx.x == 0) {
        unsigned* bar = b.bar; asm volatile("" : "+s"(bar));
        __builtin_amdgcn_s_waitcnt(0);
        unsigned nloc = b.st[0], nx = b.st[1];
        if (nloc == 0u) { xcd_barrier_complete(bar, b.x, nloc, nx); b.st[0] = nloc; b.st[1] = nx; }
        const unsigned old = xb_add(&bar[XB_XSUB(b.x)], 1u);
        const unsigned gen = old / nloc;
        if (old + 1u == (gen + 1u) * nloc) {
            __builtin_amdgcn_fence(__ATOMIC_RELEASE, "agent");
            asm volatile("s_waitcnt vmcnt(0)" ::: "memory");
            const unsigned og = xb_add(&bar[XB_TOP], 1u);
            const unsigned tg = og / nx;
            if (og + 1u == (tg + 1u) * nx) xb_add(&bar[XB_TOPGEN], 1u);
            else XB_SPIN(xb_ld(&bar[XB_TOPGEN]) == tg, bar);
            __builtin_amdgcn_fence(__ATOMIC_ACQUIRE, "agent");
            xb_add(&bar[XB_XGEN(b.x)], 1u);
            asm volatile("s_waitcnt vmcnt(0)" ::: "memory");
        } else {
            XB_SPIN(xb_ld(&bar[XB_XGEN(b.x)]) == gen, bar);
            __builtin_amdgcn_fence(__ATOMIC_ACQUIRE, "agent");
            asm volatile("s_waitcnt vmcnt(0)" ::: "memory");
        }
    }
    __syncthreads();
}
typedef unsigned u32x2_t __attribute__((ext_vector_type(2)));
__device__ __forceinline__ void gdn_unit(LAS unsigned char* lds, int tid, int lane, int wave, int b, int h, const bf16* PROJ, const float* SMALL, bf16* O,
                                         const float* convw, float a_log, float dt_bias, const float* normw) {
    LAS bf16* Qb = (LAS bf16*)(lds + 0); LAS bf16* Kb = (LAS bf16*)(lds + 8704); LAS bf16* QGb = (LAS bf16*)(lds + 17408);
    LAS bf16* KDT = (LAS bf16*)(lds + 26112);
    LAS bf16* RHS = (LAS bf16*)(lds + 36352); LAS float* UT = (LAS float*)(lds + 36352); LAS float* OS = (LAS float*)(lds + 36352);
    LAS bf16* VNT = (LAS bf16*)(lds + 54784);
    LAS bf16* St = (LAS bf16*)(lds + 65024);
    LAS bf16* AQK = (LAS bf16*)(lds + 99840);
    LAS float* Lf = (LAS float*)(lds + 102400);
    LAS bf16* Wb = (LAS bf16*)(lds + 107008);
    LAS float* gcs = (LAS float*)(lds + 115712); LAS float* bts = gcs + 32; LAS float* egs = bts + 32; LAS float* ekd = egs + 32; LAS float* gls = ekd + 32;
    const int fr = lane & 15, fq = lane >> 4;
    f32x4 Sacc[8];
#pragma unroll
    for (int j = 0; j < 8; ++j) Sacc[j] = (f32x4){0.f, 0.f, 0.f, 0.f};
    for (int e = tid; e < 128 * 136 / 2; e += NT) ((LAS unsigned*)St)[e] = 0u;
    const int cp = tid % 192, th = tid / 192, sec = cp >> 6, c2 = (cp & 63) * 2, col = sec * 512 + h * 128 + c2;
    float cw[4][2];
#pragma unroll
    for (int j = 0; j < 4; ++j) { cw[j][0] = convw[j * 1536 + col]; cw[j][1] = convw[j * 1536 + col + 1]; }
    const float Aexp = __expf(a_log), nw0 = normw[2 * lane], nw1 = normw[2 * lane + 1];
    const size_t rowb = (size_t)b * SEQ;
    unsigned raw[19]; float smb = 0.f, sma = 0.f;
#define GDN_PREFETCH(cn) do { const int ts_ = (cn) * 32 + th * 16; \
        if (tid < 384) { const bf16* pb_ = PROJ + (rowb + ts_) * PE + col; _Pragma("unroll") for (int j = 0; j < 19; ++j) { raw[j] = (j >= 3 || ts_ > 0) ? *(const unsigned*)(pb_ + (j - 3) * PE) : 0u; } } \
        else if (tid < 416) { const float* sm = SMALL + (rowb + (cn) * 32 + (tid - 384)) * 32; smb = sm[h]; sma = sm[4 + h]; } } while (0)
    GDN_PREFETCH(0);
    LDS_BARRIER();
    const int tid_in = tid, wave_in = wave;
    for (int c = 0; c < SEQ / 32; ++c) {
        int tid_l = tid_in, wave_l = wave_in; asm volatile("" : "+v"(tid_l), "+s"(wave_l));
        const int tid = tid_l, wave = wave_l, lane = tid & 63, fr = lane & 15, fq = lane >> 4, cp = tid % 192, th = tid / 192, sec = cp >> 6, c2 = (cp & 63) * 2, col = sec * 512 + h * 128 + c2;
        const int t0 = c * 32;
        float y0[16], y1[16];
        if (tid < 384) {
#pragma unroll
            for (int i = 0; i < 16; ++i) {
                y0[i] = silu(cw[0][0] * bflo(raw[i]) + cw[1][0] * bflo(raw[i + 1]) + cw[2][0] * bflo(raw[i + 2]) + cw[3][0] * bflo(raw[i + 3]));
                y1[i] = silu(cw[0][1] * bfhi(raw[i]) + cw[1][1] * bfhi(raw[i + 1]) + cw[2][1] * bfhi(raw[i + 2]) + cw[3][1] * bfhi(raw[i + 3])); }
            if (sec < 2) {
                const float qs_ = sec == 0 ? 0.08838834764831845f : 1.f;
#pragma unroll
                for (int i = 0; i < 16; ++i) { const float sc = qs_ * frsq(wave_sum(y0[i] * y0[i] + y1[i] * y1[i]) + L2_EPS); y0[i] *= sc; y1[i] *= sc; }
            }
        } else if (tid < 448) {
            float g = -Aexp * softplus(sma + dt_bias);
#pragma unroll
            for (int o = 1; o < 32; o <<= 1) { const float t_ = __shfl_up(g, o); if ((lane & 31) >= o) g += t_; }
            const float gl = __shfl(g, 31);
            if (lane < 32) { gcs[lane] = g; bts[lane] = sigm(smb); egs[lane] = __expf(g); ekd[lane] = __expf(gl - g); if (lane == 0) gls[0] = __expf(gl); }
        }
        if (c + 1 < SEQ / 32) GDN_PREFETCH(c + 1);
        unsigned zg[4];
#pragma unroll
        for (int i = 0; i < 4; ++i) zg[i] = *(const unsigned*)(PROJ + (rowb + t0 + wave * 4) * PE + 1536 + h * 128 + 2 * lane + i * PE);
        LDS_BARRIER();
        if (tid < 384) {
#pragma unroll
            for (int i = 0; i < 16; ++i) { const int r = th * 16 + i;
                if (sec == 0) { const float eg = egs[r]; *(LAS unsigned*)(Qb + r * 136 + c2) = pk2(y0[i], y1[i]); *(LAS unsigned*)(QGb + r * 136 + c2) = pk2(y0[i] * eg, y1[i] * eg); }
                else if (sec == 1) { const float ek = ekd[r], be = bts[r] * egs[r]; *(LAS unsigned*)(Kb + r * 136 + c2) = pk2(y0[i], y1[i]);
                    KDT[c2 * 40 + r] = (bf16)f2bf(y0[i] * ek); KDT[(c2 + 1) * 40 + r] = (bf16)f2bf(y1[i] * ek); *(LAS unsigned*)(RHS + r * 264 + 128 + c2) = pk2(y0[i] * be, y1[i] * be); }
                else { const float bt = bts[r]; *(LAS unsigned*)(RHS + r * 264 + c2) = pk2(y0[i] * bt, y1[i] * bt); } }
        }
        LDS_BARRIER();
        {
            const int which = wave >> 2, it = (wave >> 1) & 1, jt = wave & 1;
            f32x4 acc = (f32x4){0.f, 0.f, 0.f, 0.f};
            const LAS bf16* yb = (which ? Qb : Kb) + (it * 16 + fr) * 136 + 8 * fq; const LAS bf16* xb = Kb + (jt * 16 + fr) * 136 + 8 * fq;
#pragma unroll
            for (int kk = 0; kk < 4; ++kk) acc = __builtin_amdgcn_mfma_f32_16x16x32_bf16(*(const LAS bf16x8_t*)(xb + kk * 32), *(const LAS bf16x8_t*)(yb + kk * 32), acc, 0, 0, 0);
            const int i = it * 16 + fr, j0 = jt * 16 + 4 * fq; const float gi = gcs[i], bi = bts[i]; const f32x4 gj = *(const LAS f32x4*)(gcs + j0);
            float o4[4];
#pragma unroll
            for (int jj = 0; jj < 4; ++jj) { const int j = j0 + jj; const bool keep = which ? (j <= i) : (j < i); o4[jj] = keep ? acc[jj] * __expf(gi - gj[jj]) * (which ? 1.f : bi) : 0.f; }
            if (which == 0) *(LAS f32x4*)(Lf + i * 36 + j0) = (f32x4){o4[0], o4[1], o4[2], o4[3]};
            else *(LAS u32x2_t*)(AQK + i * 40 + j0) = (u32x2_t){pk2(o4[0], o4[1]), pk2(o4[2], o4[3])};
        }
        f32x2 us2[16];
        if (tid < 256) {
#pragma unroll
            for (int i = 0; i < 16; ++i) us2[i] = (f32x2){bflo((unsigned)RHS[(2 * i) * 264 + tid]), bflo((unsigned)RHS[(2 * i + 1) * 264 + tid])};
        }
        LDS_BARRIER();
        if (tid < 256) {
#pragma unroll
            for (int i = 1; i < 32; ++i) { f32x2 a0 = (f32x2){0.f, 0.f}, a1 = (f32x2){0.f, 0.f}; __builtin_amdgcn_sched_barrier(0);
#pragma unroll
                for (int j4 = 0; j4 < 8; ++j4) if (4 * j4 < i) { const f32x4 l4 = *(const LAS f32x4*)(Lf + i * 36 + 4 * j4); a0 += (f32x2){l4.x, l4.y} * us2[2 * j4]; a1 += (f32x2){l4.z, l4.w} * us2[2 * j4 + 1]; }
                const float sub = (a0.x + a0.y) + (a1.x + a1.y);
                if (i & 1) us2[i >> 1].y -= sub; else us2[i >> 1].x -= sub; }
            if (tid < 128) {
#pragma unroll
                for (int i = 0; i < 16; i += 2) *(LAS f32x4*)(UT + tid * 36 + 2 * i) = (f32x4){us2[i].x, us2[i].y, us2[i + 1].x, us2[i + 1].y};
            } else {
#pragma unroll
                for (int i = 0; i < 16; ++i) { Wb[(2 * i) * 136 + (tid - 128)] = (bf16)f2bf(us2[i].x); Wb[(2 * i + 1) * 136 + (tid - 128)] = (bf16)f2bf(us2[i].y); }
            }
        }
        LDS_BARRIER();
        const int it = wave & 1, vtb = (wave >> 1) * 2;
#pragma unroll
        for (int q = 0; q < 2; ++q) { const int vt = vtb + q; f32x4 acc = (f32x4){0.f, 0.f, 0.f, 0.f};
            const LAS bf16* xb = Wb + (it * 16 + fr) * 136 + 8 * fq; const LAS bf16* yb = St + (vt * 16 + fr) * 136 + 8 * fq;
#pragma unroll
            for (int kk = 0; kk < 4; ++kk) acc = __builtin_amdgcn_mfma_f32_16x16x32_bf16(*(const LAS bf16x8_t*)(xb + kk * 32), *(const LAS bf16x8_t*)(yb + kk * 32), acc, 0, 0, 0);
            const f32x4 u4 = *(const LAS f32x4*)(UT + (vt * 16 + fr) * 36 + it * 16 + 4 * fq); const f32x4 vn = u4 - acc;
            *(LAS u32x2_t*)(VNT + (vt * 16 + fr) * 40 + it * 16 + 4 * fq) = (u32x2_t){pk2(vn.x, vn.y), pk2(vn.z, vn.w)}; }
        LDS_BARRIER();
#pragma unroll
        for (int q = 0; q < 2; ++q) { const int vt = vtb + q; f32x4 acc = (f32x4){0.f, 0.f, 0.f, 0.f};
            const LAS bf16* xb = QGb + (it * 16 + fr) * 136 + 8 * fq; const LAS bf16* yb = St + (vt * 16 + fr) * 136 + 8 * fq;
#pragma unroll
            for (int kk = 0; kk < 4; ++kk) acc = __builtin_amdgcn_mfma_f32_16x16x32_bf16(*(const LAS bf16x8_t*)(xb + kk * 32), *(const LAS bf16x8_t*)(yb + kk * 32), acc, 0, 0, 0);
            acc = __builtin_amdgcn_mfma_f32_16x16x32_bf16(*(const LAS bf16x8_t*)(AQK + (it * 16 + fr) * 40 + 8 * fq), *(const LAS bf16x8_t*)(VNT + (vt * 16 + fr) * 40 + 8 * fq), acc, 0, 0, 0);
#pragma unroll
            for (int jj = 0; jj < 4; ++jj) OS[(it * 16 + 4 * fq + jj) * 132 + vt * 16 + fr] = acc[jj]; }
        {
            const float gl = gls[0]; const bf16x8_t xk = *(const LAS bf16x8_t*)(KDT + (wave * 16 + fr) * 40 + 8 * fq);
#pragma unroll
            for (int vt = 0; vt < 8; ++vt) Sacc[vt] = __builtin_amdgcn_mfma_f32_16x16x32_bf16(xk, *(const LAS bf16x8_t*)(VNT + (vt * 16 + fr) * 40 + 8 * fq), Sacc[vt] * gl, 0, 0, 0);
        }
        LDS_BARRIER();
#pragma unroll
        for (int vt = 0; vt < 8; ++vt) *(LAS u32x2_t*)(St + (vt * 16 + fr) * 136 + wave * 16 + 4 * fq) = (u32x2_t){pk2(Sacc[vt].x, Sacc[vt].y), pk2(Sacc[vt].z, Sacc[vt].w)};
#pragma unroll
        for (int i = 0; i < 4; ++i) { const int t = wave * 4 + i; const f32x2 x = *((const LAS f32x2*)(OS + t * 132) + lane);
            const float r = frsq(wave_sum(x.x * x.x + x.y * x.y) * (1.f / 128.f) + NORM_EPS);
            *(unsigned*)(O + (rowb + t0 + t) * D + h * 128 + 2 * lane) = pk2(x.x * r * nw0 * silu(bflo(zg[i])), x.y * r * nw1 * silu(bfhi(zg[i]))); }
    }
    LDS_BARRIER();
#undef GDN_PREFETCH
}
__device__ __forceinline__ void gla_unit(LAS unsigned char* lds, int tid, int lane, int wave, int b, int h, const bf16* PROJ, const float* SMALL, bf16* O,
                                         const float* gw2, const float* gb, const float* normw) {
    LAS float* qs = (LAS float*)lds; LAS float* ks = qs + 4096; LAS float* as = ks + 4096; LAS float* vs = as + 4096; LAS float* os = vs + 8192; LAS float* gl = os + 8192;
    const int v = tid >> 2, kq = tid & 3;
    f32x2 S[8];
#pragma unroll
    for (int j = 0; j < 8; ++j) S[j] = (f32x2){0.f, 0.f};
    const int ach = tid & 63, atg = tid >> 6;
    float w2c[16];
#pragma unroll
    for (int r = 0; r < 16; ++r) w2c[r] = gw2[r * 256 + h * 64 + ach];
    const float gbc = gb[h * 64 + ach], nw0 = normw[2 * lane], nw1 = normw[2 * lane + 1];
    const size_t rowb = (size_t)b * SEQ;
    unsigned rq[4], rk[4], rv[8]; float rg[2];
#define GLA_PREFETCH(cn) do { const size_t r0_ = rowb + (cn) * 64; \
        const bf16* pq_ = PROJ + (r0_ + (tid >> 5)) * PE + h * 64 + 2 * (tid & 31); const bf16* pv_ = PROJ + (r0_ + (tid >> 6)) * PE + 2560 + h * 128 + 2 * (tid & 63); const float* pg_ = SMALL + (r0_ + (tid >> 4)) * 32 + 8 + (tid & 15); \
        _Pragma("unroll") for (int i = 0; i < 4; ++i) { rq[i] = *(const unsigned*)(pq_ + 2048 + i * 16 * PE); rk[i] = *(const unsigned*)(pq_ + 2304 + i * 16 * PE); } \
        _Pragma("unroll") for (int i = 0; i < 8; ++i) { rv[i] = *(const unsigned*)(pv_ + i * 8 * PE); } \
        _Pragma("unroll") for (int i = 0; i < 2; ++i) { rg[i] = pg_[i * 32 * 32]; } } while (0)
    GLA_PREFETCH(0);
    for (int c = 0; c < SEQ / 64; ++c) {
        const int t0 = c * 64;
#pragma unroll
        for (int i = 0; i < 4; ++i) { const int e = tid + i * NT, t = e >> 5, p = e & 31;
            *(LAS f32x2*)(qs + t * 64 + 2 * p) = (f32x2){bflo(rq[i]) * 0.125f, bfhi(rq[i]) * 0.125f}; *(LAS f32x2*)(ks + t * 64 + 2 * p) = (f32x2){bflo(rk[i]), bfhi(rk[i])}; }
#pragma unroll
        for (int i = 0; i < 8; ++i) { const int e = tid + i * NT, t = e >> 6, p = e & 63; *(LAS f32x2*)(vs + t * 128 + 2 * p) = (f32x2){bflo(rv[i]), bfhi(rv[i])}; }
#pragma unroll
        for (int i = 0; i < 2; ++i) gl[tid + i * NT] = rg[i];
        if (c + 1 < SEQ / 64) GLA_PREFETCH(c + 1);
        unsigned zg[8];
#pragma unroll
        for (int i = 0; i < 8; ++i) zg[i] = *(const unsigned*)(PROJ + (rowb + t0 + wave * 8) * PE + 3072 + h * 128 + 2 * lane + i * PE);
        LDS_BARRIER();
#pragma unroll
        for (int i = 0; i < 8; ++i) { const int t = atg * 8 + i; float la = gbc;
#pragma unroll
            for (int r = 0; r < 16; r += 4) { const f32x4 g4 = *(const LAS f32x4*)(gl + t * 16 + r); la += (g4.x * w2c[r] + g4.y * w2c[r + 1]) + (g4.z * w2c[r + 2] + g4.w * w2c[r + 3]); }
            as[t * 64 + ach] = __expf(fmaxf(-softplus(-la) * (1.f / 16.f), -1.f)); }
        LDS_BARRIER();
        {
            f32x4 kc[4], qc[4], ac[4]; float vc = vs[v];
#pragma unroll
            for (int i = 0; i < 4; ++i) { kc[i] = *(const LAS f32x4*)(ks + 4 * kq + 16 * i); qc[i] = *(const LAS f32x4*)(qs + 4 * kq + 16 * i); ac[i] = *(const LAS f32x4*)(as + 4 * kq + 16 * i); }
#pragma unroll 2
            for (int t = 0; t < 64; ++t) {
                const int tn = t < 63 ? t + 1 : 63;
                f32x4 kn[4], qn[4], an[4]; const float vnx = vs[tn * 128 + v];
#pragma unroll
                for (int i = 0; i < 4; ++i) { kn[i] = *(const LAS f32x4*)(ks + tn * 64 + 4 * kq + 16 * i); qn[i] = *(const LAS f32x4*)(qs + tn * 64 + 4 * kq + 16 * i); an[i] = *(const LAS f32x4*)(as + tn * 64 + 4 * kq + 16 * i); }
                f32x2 po = (f32x2){0.f, 0.f};
#pragma unroll
                for (int i = 0; i < 4; ++i) {
                    S[2 * i] = S[2 * i] * (f32x2){ac[i].x, ac[i].y} + (f32x2){kc[i].x, kc[i].y} * vc; S[2 * i + 1] = S[2 * i + 1] * (f32x2){ac[i].z, ac[i].w} + (f32x2){kc[i].z, kc[i].w} * vc;
                    po += S[2 * i] * (f32x2){qc[i].x, qc[i].y}; po += S[2 * i + 1] * (f32x2){qc[i].z, qc[i].w}; }
                const float o = red4(po.x + po.y);
                if (kq == 0) os[t * 128 + v] = o;
#pragma unroll
                for (int i = 0; i < 4; ++i) { kc[i] = kn[i]; qc[i] = qn[i]; ac[i] = an[i]; }
                vc = vnx;
            }
        }
        LDS_BARRIER();
#pragma unroll
        for (int i = 0; i < 8; ++i) { const int t = wave * 8 + i; const f32x2 x = *((const LAS f32x2*)(os + t * 128) + lane);
            const float r = frsq(wave_sum(x.x * x.x + x.y * x.y) * (1.f / 128.f) + NORM_EPS);
            *(unsigned*)(O + (rowb + t0 + t) * D + 512 + h * 128 + 2 * lane) = pk2(x.x * r * nw0 * silu(bflo(zg[i])), x.y * r * nw1 * silu(bfhi(zg[i]))); }
        LDS_BARRIER();
    }
#undef GLA_PREFETCH
}
constexpr int GI_QG = 0, GI_KDT = 8704, GI_AQK = 18944, GI_W = 21504, GI_UT = 30208, GI_GL = 40448, GI_BYTES = 40512;
__device__ __forceinline__ void gdn_phase_a(LAS unsigned char* lds, int tid_in, int wave_in, int first, int stride, const bf16* PROJ, const float* SMALL, unsigned char* GS, const float* convw_l, const float* gdn_alog, const float* gdn_dtb) {
    LAS bf16* QGb = (LAS bf16*)(lds + GI_QG); LAS bf16* KDT = (LAS bf16*)(lds + GI_KDT); LAS bf16* AQK = (LAS bf16*)(lds + GI_AQK); LAS bf16* Wb = (LAS bf16*)(lds + GI_W); LAS bf16* UTb = (LAS bf16*)(lds + GI_UT);
    LAS bf16* Qb = (LAS bf16*)(lds + 40512); LAS bf16* Kb = (LAS bf16*)(lds + 49216); LAS bf16* RHS = (LAS bf16*)(lds + 57920); LAS float* Lf = (LAS float*)(lds + 74816);
    LAS float* gcs = (LAS float*)(lds + 79424); LAS float* bts = gcs + 32; LAS float* egs = bts + 32; LAS float* ekd = egs + 32; LAS float* gls = ekd + 32;
    unsigned raw[19]; float smb = 0.f, sma = 0.f, cwn[4][2];
#define GDNA_PREFETCH(item) do { const int c_ = (item) & 63, h_ = ((item) >> 6) & 3, b_ = (item) >> 8; const int cp_ = tid_in % 192, th_ = tid_in / 192, col_ = (cp_ >> 6) * 512 + h_ * 128 + (cp_ & 63) * 2; const int ts_ = c_ * 32 + th_ * 16; \
        if (tid_in < 384) { const bf16* pb_ = PROJ + ((size_t)b_ * SEQ + ts_) * PE + col_; _Pragma("unroll") for (int j = 0; j < 19; ++j) { raw[j] = (j >= 3 || ts_ > 0) ? *(const unsigned*)(pb_ + (j - 3) * PE) : 0u; } \
            _Pragma("unroll") for (int j = 0; j < 4; ++j) { cwn[j][0] = convw_l[j * 1536 + col_]; cwn[j][1] = convw_l[j * 1536 + col_ + 1]; } } \
        else if (tid_in < 416) { const float* sm = SMALL + ((size_t)b_ * SEQ + c_ * 32 + (tid_in - 384)) * 32; smb = sm[h_]; sma = sm[4 + h_]; } } while (0)
    if (first < 4096) GDNA_PREFETCH(first);
    for (int item = first; item < 4096; item += stride) {
        int tid_l = tid_in, wave_l = wave_in; asm volatile("" : "+v"(tid_l), "+s"(wave_l));
        const int tid = tid_l, wave = wave_l, lane = tid & 63, fr = lane & 15, fq = lane >> 4, cp = tid % 192, th = tid / 192, sec = cp >> 6, c2 = (cp & 63) * 2;
        float y0[16], y1[16];
        if (tid < 384) {
            f32x2 xv[19];
#pragma unroll
            for (int j = 0; j < 19; ++j) xv[j] = (f32x2){bflo(raw[j]), bfhi(raw[j])};
            const f32x2 c0v = {cwn[0][0], cwn[0][1]}, c1v = {cwn[1][0], cwn[1][1]}, c2v = {cwn[2][0], cwn[2][1]}, c3v = {cwn[3][0], cwn[3][1]};
#pragma unroll
            for (int i = 0; i < 16; ++i) { const f32x2 yv = silu2((c0v * xv[i] + c1v * xv[i + 1]) + (c2v * xv[i + 2] + c3v * xv[i + 3])); y0[i] = yv.x; y1[i] = yv.y; }
            if (sec < 2) {
                const float qs_ = sec == 0 ? 0.08838834764831845f : 1.f;
#pragma unroll
                for (int i = 0; i < 16; ++i) { const float sc = qs_ * frsq(wave_sum(y0[i] * y0[i] + y1[i] * y1[i]) + L2_EPS); y0[i] *= sc; y1[i] *= sc; }
            }
        } else if (tid < 448) {
            const int h_ = (item >> 6) & 3;
            float g = -__expf(gdn_alog[h_]) * softplus(sma + gdn_dtb[h_]);
#pragma unroll
            for (int o = 1; o < 32; o <<= 1) { const float t_ = __shfl_up(g, o); if ((lane & 31) >= o) g += t_; }
            const float gl = __shfl(g, 31);
            if (lane < 32) { gcs[lane] = g; bts[lane] = sigm(smb); egs[lane] = __expf(g); ekd[lane] = __expf(gl - g); if (lane == 0) gls[0] = __expf(gl); }
        }
        if (item + stride < 4096) GDNA_PREFETCH(item + stride);
        LDS_BARRIER();
        if (tid < 384) {
            if (sec == 0) {
#pragma unroll
                for (int i = 0; i < 16; ++i) { const int r = th * 16 + i; const float eg = egs[r]; *(LAS unsigned*)(Qb + r * 136 + c2) = pk2(y0[i], y1[i]); *(LAS unsigned*)(QGb + r * 136 + c2) = pk2(y0[i] * eg, y1[i] * eg); }
            } else if (sec == 1) {
                float e0[16], e1[16];
#pragma unroll
                for (int i = 0; i < 16; ++i) { const int r = th * 16 + i; const float ek = ekd[r], be = bts[r] * egs[r]; *(LAS unsigned*)(Kb + r * 136 + c2) = pk2(y0[i], y1[i]);
                    e0[i] = y0[i] * ek; e1[i] = y1[i] * ek; *(LAS unsigned*)(RHS + r * 264 + 128 + c2) = pk2(y0[i] * be, y1[i] * be); }
#pragma unroll
                for (int h8 = 0; h8 < 2; ++h8) { *(LAS v4u*)(KDT + c2 * 40 + th * 16 + 8 * h8) = (v4u){pk2(e0[8 * h8], e0[8 * h8 + 1]), pk2(e0[8 * h8 + 2], e0[8 * h8 + 3]), pk2(e0[8 * h8 + 4], e0[8 * h8 + 5]), pk2(e0[8 * h8 + 6], e0[8 * h8 + 7])};
                    *(LAS v4u*)(KDT + (c2 + 1) * 40 + th * 16 + 8 * h8) = (v4u){pk2(e1[8 * h8], e1[8 * h8 + 1]), pk2(e1[8 * h8 + 2], e1[8 * h8 + 3]), pk2(e1[8 * h8 + 4], e1[8 * h8 + 5]), pk2(e1[8 * h8 + 6], e1[8 * h8 + 7])}; }
            } else {
#pragma unroll
                for (int i = 0; i < 16; ++i) { const int r = th * 16 + i; const float bt = bts[r]; *(LAS unsigned*)(RHS + r * 264 + c2) = pk2(y0[i] * bt, y1[i] * bt); }
            }
        } else if (tid == 448) *(LAS float*)(lds + GI_GL) = gls[0];
        LDS_BARRIER();
        {
            const int which = wave >> 2, it = (wave >> 1) & 1, jt = wave & 1;
            f32x4 acc = (f32x4){0.f, 0.f, 0.f, 0.f};
            const LAS bf16* yb = (which ? Qb : Kb) + (it * 16 + fr) * 136 + 8 * fq; const LAS bf16* xb = Kb + (jt * 16 + fr) * 136 + 8 * fq;
#pragma unroll
            for (int kk = 0; kk < 4; ++kk) acc = __builtin_amdgcn_mfma_f32_16x16x32_bf16(*(const LAS bf16x8_t*)(xb + kk * 32), *(const LAS bf16x8_t*)(yb + kk * 32), acc, 0, 0, 0);
            const int i = it * 16 + fr, j0 = jt * 16 + 4 * fq; const float gi = gcs[i], bi = bts[i]; const f32x4 gj = *(const LAS f32x4*)(gcs + j0);
            float o4[4];
#pragma unroll
            for (int jj = 0; jj < 4; ++jj) { const int j = j0 + jj; const bool keep = which ? (j <= i) : (j < i); o4[jj] = keep ? acc[jj] * __expf(gi - gj[jj]) * (which ? 1.f : bi) : 0.f; }
            if (which == 0) *(LAS f32x4*)(Lf + i * 36 + j0) = (f32x4){o4[0], o4[1], o4[2], o4[3]};
            else *(LAS u32x2_t*)(AQK + i * 40 + j0) = (u32x2_t){pk2(o4[0], o4[1]), pk2(o4[2], o4[3])};
        }
        f32x2 us2[16];
        if (tid < 256) {
#pragma unroll
            for (int i = 0; i < 16; ++i) us2[i] = (f32x2){bflo((unsigned)RHS[(2 * i) * 264 + tid]), bflo((unsigned)RHS[(2 * i + 1) * 264 + tid])};
        }
        LDS_BARRIER();
        if (tid < 256) {
            const LAS float* Lfv = Lf; asm volatile("" : "+v"(Lfv));
            f32x4 lc[8], ln[8];
#pragma unroll
            for (int j4 = 0; j4 < 8; ++j4) { lc[j4] = (f32x4){0.f, 0.f, 0.f, 0.f}; ln[j4] = lc[j4]; }
            lc[0] = *(const LAS f32x4*)(Lfv + 36);
#pragma unroll
            for (int i = 1; i < 32; ++i) { f32x2 a0 = (f32x2){0.f, 0.f}, a1 = (f32x2){0.f, 0.f}; __builtin_amdgcn_sched_barrier(0);
                if (i + 1 < 32) {
#pragma unroll
                    for (int j4 = 0; j4 < 8; ++j4) if (4 * j4 < i + 1) ln[j4] = *(const LAS f32x4*)(Lfv + (i + 1) * 36 + 4 * j4); }
#pragma unroll
                for (int j4 = 0; j4 < 8; ++j4) if (4 * j4 < i) { const f32x4 l4 = lc[j4]; a0 += (f32x2){l4.x, l4.y} * us2[2 * j4]; a1 += (f32x2){l4.z, l4.w} * us2[2 * j4 + 1]; }
                const float sub = (a0.x + a0.y) + (a1.x + a1.y);
                if (i & 1) us2[i >> 1].y -= sub; else us2[i >> 1].x -= sub;
#pragma unroll
                for (int j4 = 0; j4 < 8; ++j4) lc[j4] = ln[j4]; }
            if (tid < 128) {
#pragma unroll
                for (int i = 0; i < 16; i += 4) *(LAS v4u*)(UTb + tid * 40 + 2 * i) = (v4u){pk2(us2[i].x, us2[i].y), pk2(us2[i + 1].x, us2[i + 1].y), pk2(us2[i + 2].x, us2[i + 2].y), pk2(us2[i + 3].x, us2[i + 3].y)};
            } else {
#pragma unroll
                for (int i = 0; i < 16; ++i) { Wb[(2 * i) * 136 + (tid - 128)] = (bf16)f2bf(us2[i].x); Wb[(2 * i + 1) * 136 + (tid - 128)] = (bf16)f2bf(us2[i].y); }
            }
        }
        LDS_BARRIER();
        { v4u* dst = (v4u*)(GS + (size_t)item * GI_BYTES);
#pragma unroll
          for (int k = 0; k < 5; ++k) { const int e = tid + k * NT; if (e < GI_BYTES / 16) dst[e] = *(const LAS v4u*)(lds + e * 16); } }
    }
    LDS_BARRIER();
#undef GDNA_PREFETCH
}
__device__ __forceinline__ void gdn_phase_b(LAS unsigned char* lds, int tid_in, int wave_in, int b, int h, const bf16* PROJ, const unsigned char* GS, bf16* O, const float* normw) {
    LAS bf16* QGb = (LAS bf16*)(lds + GI_QG); LAS bf16* KDT = (LAS bf16*)(lds + GI_KDT); LAS bf16* AQK = (LAS bf16*)(lds + GI_AQK); LAS bf16* Wb = (LAS bf16*)(lds + GI_W); LAS bf16* UTb = (LAS bf16*)(lds + GI_UT);
    LAS bf16* VNT = (LAS bf16*)(lds + 40512); LAS bf16* St = (LAS bf16*)(lds + 50752); LAS float* OS = (LAS float*)(lds + 85568);
    f32x4 Sacc[8];
#pragma unroll
    for (int j = 0; j < 8; ++j) Sacc[j] = (f32x4){0.f, 0.f, 0.f, 0.f};
    for (int e = tid_in; e < 128 * 136 / 2; e += NT) ((LAS unsigned*)St)[e] = 0u;
    const float nw0 = normw[2 * (tid_in & 63)], nw1 = normw[2 * (tid_in & 63) + 1];
    const size_t rowb = (size_t)b * SEQ;
    const unsigned char* gsb = GS + (size_t)((b * 4 + h) * 64) * GI_BYTES;
    v4u ring[4][5]; unsigned zring[4][4];
#define GDNB_PREFETCH(cn, st) do { const v4u* src_ = (const v4u*)(gsb + (size_t)(cn) * GI_BYTES); _Pragma("unroll") for (int k = 0; k < 5; ++k) { const int e = tid_in + k * NT; if (e < GI_BYTES / 16) ring[st][k] = src_[e]; } \
        _Pragma("unroll") for (int i = 0; i < 4; ++i) zring[st][i] = *(const unsigned*)(PROJ + (rowb + (cn) * 32 + wave_in * 4) * PE + 1536 + h * 128 + 2 * (tid_in & 63) + i * PE); } while (0)
    GDNB_PREFETCH(0, 0); GDNB_PREFETCH(1, 1); GDNB_PREFETCH(2, 2); GDNB_PREFETCH(3, 3);
    for (int c0 = 0; c0 < SEQ / 32; c0 += 4) {
#pragma unroll
      for (int st = 0; st < 4; ++st) { const int c = c0 + st;
        int tid_l = tid_in, wave_l = wave_in; asm volatile("" : "+v"(tid_l), "+s"(wave_l));
        const int tid = tid_l, wave = wave_l, lane = tid & 63, fr = lane & 15, fq = lane >> 4;
        const int t0 = c * 32;
#pragma unroll
        for (int k = 0; k < 5; ++k) { const int e = tid + k * NT; if (e < GI_BYTES / 16) *(LAS v4u*)(lds + e * 16) = ring[st][k]; }
        unsigned zg[4];
#pragma unroll
        for (int i = 0; i < 4; ++i) zg[i] = zring[st][i];
        if (c + 4 < SEQ / 32) GDNB_PREFETCH(c + 4, st);
        LDS_BARRIER();
        const int it = wave & 1, vtb = (wave >> 1) * 2;
#pragma unroll
        for (int q = 0; q < 2; ++q) { const int vt = vtb + q; f32x4 acc = (f32x4){0.f, 0.f, 0.f, 0.f};
            const LAS bf16* xb = Wb + (it * 16 + fr) * 136 + 8 * fq; const LAS bf16* yb = St + (vt * 16 + fr) * 136 + 8 * fq;
#pragma unroll
            for (int kk = 0; kk < 4; ++kk) acc = __builtin_amdgcn_mfma_f32_16x16x32_bf16(*(const LAS bf16x8_t*)(xb + kk * 32), *(const LAS bf16x8_t*)(yb + kk * 32), acc, 0, 0, 0);
            const u32x2_t ub = *(const LAS u32x2_t*)(UTb + (vt * 16 + fr) * 40 + it * 16 + 4 * fq);
            const f32x4 vn = (f32x4){bflo(ub.x), bfhi(ub.x), bflo(ub.y), bfhi(ub.y)} - acc;
            *(LAS u32x2_t*)(VNT + (vt * 16 + fr) * 40 + it * 16 + 4 * fq) = (u32x2_t){pk2(vn.x, vn.y), pk2(vn.z, vn.w)}; }
        LDS_BARRIER();
#pragma unroll
        for (int q = 0; q < 2; ++q) { const int vt = vtb + q; f32x4 acc = (f32x4){0.f, 0.f, 0.f, 0.f};
            const LAS bf16* xb = QGb + (it * 16 + fr) * 136 + 8 * fq; const LAS bf16* yb = St + (vt * 16 + fr) * 136 + 8 * fq;
#pragma unroll
            for (int kk = 0; kk < 4; ++kk) acc = __builtin_amdgcn_mfma_f32_16x16x32_bf16(*(const LAS bf16x8_t*)(xb + kk * 32), *(const LAS bf16x8_t*)(yb + kk * 32), acc, 0, 0, 0);
            acc = __builtin_amdgcn_mfma_f32_16x16x32_bf16(*(const LAS bf16x8_t*)(AQK + (it * 16 + fr) * 40 + 8 * fq), *(const LAS bf16x8_t*)(VNT + (vt * 16 + fr) * 40 + 8 * fq), acc, 0, 0, 0);
#pragma unroll
            for (int jj = 0; jj < 4; ++jj) OS[(it * 16 + 4 * fq + jj) * 132 + vt * 16 + fr] = acc[jj]; }
        {
            const float gl = *(const LAS float*)(lds + GI_GL); const bf16x8_t xk = *(const LAS bf16x8_t*)(KDT + (wave * 16 + fr) * 40 + 8 * fq);
#pragma unroll
            for (int vt = 0; vt < 8; ++vt) Sacc[vt] = __builtin_amdgcn_mfma_f32_16x16x32_bf16(xk, *(const LAS bf16x8_t*)(VNT + (vt * 16 + fr) * 40 + 8 * fq), Sacc[vt] * gl, 0, 0, 0);
        }
        LDS_BARRIER();
#pragma unroll
        for (int vt = 0; vt < 8; ++vt) *(LAS u32x2_t*)(St + (vt * 16 + fr) * 136 + wave * 16 + 4 * fq) = (u32x2_t){pk2(Sacc[vt].x, Sacc[vt].y), pk2(Sacc[vt].z, Sacc[vt].w)};
#pragma unroll
        for (int i = 0; i < 4; ++i) { const int t = wave * 4 + i; const f32x2 x = *((const LAS f32x2*)(OS + t * 132) + lane);
            const float r = frsq(wave_sum(x.x * x.x + x.y * x.y) * (1.f / 128.f) + NORM_EPS);
            *(unsigned*)(O + (rowb + t0 + t) * D + h * 128 + 2 * lane) = pk2(x.x * r * nw0 * silu(bflo(zg[i])), x.y * r * nw1 * silu(bfhi(zg[i]))); }
      }
    }
    LDS_BARRIER();
#undef GDNB_PREFETCH
}
__device__ __forceinline__ void gla_chunked(LAS unsigned char* lds, int tid_in, int wave_in, int b, int h, const bf16* PROJ, const float* SMALL, bf16* O, const float* gw2, const float* gb, const float* normw) {
    LAS bf16* QG = (LAS bf16*)(lds + 0); LAS bf16* KG = (LAS bf16*)(lds + 4608); LAS bf16* KDT = (LAS bf16*)(lds + 9216); LAS bf16* VT = (LAS bf16*)(lds + 14336); LAS bf16* ATT = (LAS bf16*)(lds + 24576);
    LAS bf16* ST = (LAS bf16*)(lds + 27136); LAS float* OS = (LAS float*)(lds + 45568); LAS float* LA = (LAS float*)(lds + 62464); LAS float* GLR = (LAS float*)(lds + 70656); LAS float* GLS = (LAS float*)(lds + 72704);
    f32x4 Sacc[4];
#pragma unroll
    for (int j = 0; j < 4; ++j) Sacc[j] = (f32x4){0.f, 0.f, 0.f, 0.f};
    for (int e = tid_in; e < 128 * 72 / 2; e += NT) ((LAS unsigned*)ST)[e] = 0u;
    float w2c[16];
#pragma unroll
    for (int r = 0; r < 16; ++r) w2c[r] = gw2[r * 256 + h * 64 + (tid_in & 63)];
    const float gbc = gb[h * 64 + (tid_in & 63)], nw0 = normw[2 * (tid_in & 63)], nw1 = normw[2 * (tid_in & 63) + 1];
    const size_t rowb = (size_t)b * SEQ;
    unsigned rq[2], rk[2], rv[4]; float rg;
#define GLA2_PREFETCH(cn) do { const size_t r0_ = rowb + (cn) * 32; \
        const bf16* pq_ = PROJ + (r0_ + (tid_in >> 5)) * PE + h * 64 + 2 * (tid_in & 31); const bf16* pv_ = PROJ + (r0_ + (tid_in >> 6)) * PE + 2560 + h * 128 + 2 * (tid_in & 63); \
        _Pragma("unroll") for (int i = 0; i < 2; ++i) { rq[i] = *(const unsigned*)(pq_ + 2048 + i * 16 * PE); rk[i] = *(const unsigned*)(pq_ + 2304 + i * 16 * PE); } \
        _Pragma("unroll") for (int i = 0; i < 4; ++i) { rv[i] = *(const unsigned*)(pv_ + i * 8 * PE); } \
        rg = SMALL[(r0_ + (tid_in >> 4)) * 32 + 8 + (tid_in & 15)]; } while (0)
    GLA2_PREFETCH(0);
    LDS_BARRIER();
    for (int c = 0; c < SEQ / 32; ++c) {
        int tid_l = tid_in, wave_l = wave_in; asm volatile("" : "+v"(tid_l), "+s"(wave_l));
        const int tid = tid_l, wave = wave_l, lane = tid & 63, fr = lane & 15, fq = lane >> 4;
        const int t0 = c * 32;
        GLR[tid] = rg;
        const unsigned cq0 = rq[0], cq1 = rq[1], ck0 = rk[0], ck1 = rk[1], cv0 = rv[0], cv1 = rv[1], cv2 = rv[2], cv3 = rv[3];
        if (c + 1 < SEQ / 32) GLA2_PREFETCH(c + 1);
        unsigned zg[4];
#pragma unroll
        for (int i = 0; i < 4; ++i) zg[i] = *(const unsigned*)(PROJ + (rowb + t0 + wave * 4) * PE + 3072 + h * 128 + 2 * lane + i * PE);
        LDS_BARRIER();
#pragma unroll
        for (int i = 0; i < 4; ++i) { const int t = wave * 4 + i; float la = gbc;
#pragma unroll
            for (int r = 0; r < 16; r += 4) { const f32x4 g4 = *(const LAS f32x4*)(GLR + t * 16 + r); la += (g4.x * w2c[r] + g4.y * w2c[r + 1]) + (g4.z * w2c[r + 2] + g4.w * w2c[r + 3]); }
            LA[t * 64 + lane] = fmaxf(-softplus(-la) * (1.f / 16.f), -1.f); }
        LDS_BARRIER();
        if (tid < 64) { float acc = 0.f, col[32];
#pragma unroll
            for (int t = 0; t < 32; ++t) col[t] = LA[t * 64 + tid];
#pragma unroll
            for (int t = 0; t < 32; ++t) { acc += col[t]; LA[t * 64 + tid] = acc; }
            GLS[tid] = __expf(acc); }
        LDS_BARRIER();
        {
            const unsigned cqs[2] = {cq0, cq1}, cks[2] = {ck0, ck1}, cvs[4] = {cv0, cv1, cv2, cv3};
#pragma unroll
            for (int i = 0; i < 2; ++i) { const int t = (tid >> 5) + 16 * i, p = tid & 31; const f32x2 gc = *(const LAS f32x2*)(LA + t * 64 + 2 * p); const f32x2 gls = *(const LAS f32x2*)(GLS + 2 * p);
                const float e0 = __expf(gc.x), e1 = __expf(gc.y), n0 = __expf(-gc.x), n1 = __expf(-gc.y), k0 = bflo(cks[i]), k1 = bfhi(cks[i]);
                *(LAS unsigned*)(QG + t * 72 + 2 * p) = pk2(bflo(cqs[i]) * 0.125f * e0, bfhi(cqs[i]) * 0.125f * e1);
                *(LAS unsigned*)(KG + t * 72 + 2 * p) = pk2(k0 * n0, k1 * n1);
                KDT[(2 * p) * 40 + t] = (bf16)f2bf(k0 * n0 * gls.x); KDT[(2 * p + 1) * 40 + t] = (bf16)f2bf(k1 * n1 * gls.y); }
#pragma unroll
            for (int i = 0; i < 4; ++i) { const int t = (tid >> 6) + 8 * i, p = tid & 63; VT[(2 * p) * 40 + t] = (bf16)(cvs[i] & 0xffffu); VT[(2 * p + 1) * 40 + t] = (bf16)(cvs[i] >> 16); }
        }
        LDS_BARRIER();
        if (wave < 4) { const int it = wave >> 1, jt = wave & 1; f32x4 acc = (f32x4){0.f, 0.f, 0.f, 0.f};
#pragma unroll
            for (int kk = 0; kk < 2; ++kk) acc = __builtin_amdgcn_mfma_f32_16x16x32_bf16(*(const LAS bf16x8_t*)(KG + (jt * 16 + fr) * 72 + kk * 32 + 8 * fq), *(const LAS bf16x8_t*)(QG + (it * 16 + fr) * 72 + kk * 32 + 8 * fq), acc, 0, 0, 0);
            const int i = it * 16 + fr, j0 = jt * 16 + 4 * fq;
            *(LAS u32x2_t*)(ATT + i * 40 + j0) = (u32x2_t){pk2(j0 <= i ? acc.x : 0.f, j0 + 1 <= i ? acc.y : 0.f), pk2(j0 + 2 <= i ? acc.z : 0.f, j0 + 3 <= i ? acc.w : 0.f)}; }
        LDS_BARRIER();
        {
            const int it = wave & 1, vtb = (wave >> 1) * 2;
#pragma unroll
            for (int q = 0; q < 2; ++q) { const int vt = vtb + q; f32x4 acc = (f32x4){0.f, 0.f, 0.f, 0.f};
#pragma unroll
                for (int kk = 0; kk < 2; ++kk) acc = __builtin_amdgcn_mfma_f32_16x16x32_bf16(*(const LAS bf16x8_t*)(QG + (it * 16 + fr) * 72 + kk * 32 + 8 * fq), *(const LAS bf16x8_t*)(ST + (vt * 16 + fr) * 72 + kk * 32 + 8 * fq), acc, 0, 0, 0);
                acc = __builtin_amdgcn_mfma_f32_16x16x32_bf16(*(const LAS bf16x8_t*)(ATT + (it * 16 + fr) * 40 + 8 * fq), *(const LAS bf16x8_t*)(VT + (vt * 16 + fr) * 40 + 8 * fq), acc, 0, 0, 0);
#pragma unroll
                for (int jj = 0; jj < 4; ++jj) OS[(it * 16 + 4 * fq + jj) * 132 + vt * 16 + fr] = acc[jj]; }
            const int kt = wave & 3, vt0 = (wave >> 2) * 4; const f32x4 glv = *(const LAS f32x4*)(GLS + kt * 16 + 4 * fq); const bf16x8_t xk = *(const LAS bf16x8_t*)(KDT + (kt * 16 + fr) * 40 + 8 * fq);
#pragma unroll
            for (int q = 0; q < 4; ++q) Sacc[q] = __builtin_amdgcn_mfma_f32_16x16x32_bf16(xk, *(const LAS bf16x8_t*)(VT + ((vt0 + q) * 16 + fr) * 40 + 8 * fq), Sacc[q] * glv, 0, 0, 0);
        }
        LDS_BARRIER();
        { const int kt = wave & 3, vt0 = (wave >> 2) * 4;
#pragma unroll
          for (int q = 0; q < 4; ++q) *(LAS u32x2_t*)(ST + ((vt0 + q) * 16 + fr) * 72 + kt * 16 + 4 * fq) = (u32x2_t){pk2(Sacc[q].x, Sacc[q].y), pk2(Sacc[q].z, Sacc[q].w)}; }
#pragma unroll
        for (int i = 0; i < 4; ++i) { const int t = wave * 4 + i; const f32x2 x = *((const LAS f32x2*)(OS + t * 132) + lane);
            const float r = frsq(wave_sum(x.x * x.x + x.y * x.y) * (1.f / 128.f) + NORM_EPS);
            *(unsigned*)(O + (rowb + t0 + t) * D + 512 + h * 128 + 2 * lane) = pk2(x.x * r * nw0 * silu(bflo(zg[i])), x.y * r * nw1 * silu(bfhi(zg[i]))); }
    }
    LDS_BARRIER();
#undef GLA2_PREFETCH
}
__device__ __forceinline__ void ssd_unit(LAS unsigned char* lds, int tid, int lane, int wave, int b, int hd, const bf16* PROJ, const float* SMALL, bf16* O,
                                         const float* convw, const float* convb, float dt_bias, float a_log, float dskip) {
    LAS float* xs = (LAS float*)lds; LAS float* Bs = xs + 4096; LAS float* Cs = Bs + 8192; LAS float* ys = Cs + 8192; LAS float* dts = ys + 4096; LAS float* das = dts + 64;
    const int p = tid >> 3, nq = tid & 7, g = hd >> 2;
    f32x2 Hs[8];
#pragma unroll
    for (int j = 0; j < 8; ++j) Hs[j] = (f32x2){0.f, 0.f};
    const int cp = tid % 160, th = tid / 160;
    const int xc = cp < 32 ? hd * 64 + 2 * cp : (cp < 96 ? 512 + g * 128 + 2 * (cp - 32) : 768 + g * 128 + 2 * (cp - 96));
    const int col = 512 + xc;
    float cw[4][2];
#pragma unroll
    for (int j = 0; j < 4; ++j) { cw[j][0] = convw[j * 1024 + xc]; cw[j][1] = convw[j * 1024 + xc + 1]; }
    const float cb0 = convb[xc], cb1 = convb[xc + 1];
    const float Aneg = -__expf(a_log);
    const size_t rowb = (size_t)b * SEQ;
    unsigned raw[35]; float dtr = 0.f;
#define SSD_PREFETCH(cn) do { const int ts_ = (cn) * 64 + th * 32; \
        if (tid < 320) { const bf16* pb_ = PROJ + (rowb + ts_) * PO + col; _Pragma("unroll") for (int j = 0; j < 35; ++j) { raw[j] = (j >= 3 || ts_ > 0) ? *(const unsigned*)(pb_ + (j - 3) * PO) : 0u; } } \
        else if (tid < 384) dtr = SMALL[(rowb + (cn) * 64 + (tid - 320)) * 32 + hd]; } while (0)
    SSD_PREFETCH(0);
    for (int c = 0; c < SEQ / 64; ++c) {
        const int t0 = c * 64;
        if (tid < 320) {
            LAS float* dst = (cp < 32 ? xs + (th * 32) * 64 + 2 * cp : (cp < 96 ? Bs + (th * 32) * 128 + 2 * (cp - 32) : Cs + (th * 32) * 128 + 2 * (cp - 96)));
            const int dstride = cp < 32 ? 64 : 128;
#pragma unroll
            for (int i = 0; i < 32; ++i) {
                const float y0 = cw[0][0] * bflo(raw[i]) + cw[1][0] * bflo(raw[i + 1]) + cw[2][0] * bflo(raw[i + 2]) + cw[3][0] * bflo(raw[i + 3]) + cb0;
                const float y1 = cw[0][1] * bfhi(raw[i]) + cw[1][1] * bfhi(raw[i + 1]) + cw[2][1] * bfhi(raw[i + 2]) + cw[3][1] * bfhi(raw[i + 3]) + cb1;
                *(LAS f32x2*)(dst + i * dstride) = (f32x2){silu(y0), silu(y1)};
            }
        } else if (tid < 384) { const int t = tid - 320; const float dt = softplus(dtr + dt_bias); dts[t] = dt; das[t] = __expf(dt * Aneg); }
        if (c + 1 < SEQ / 64) SSD_PREFETCH(c + 1);
        unsigned zg[4];
#pragma unroll
        for (int i = 0; i < 4; ++i) zg[i] = *(const unsigned*)(PROJ + (rowb + t0 + (tid >> 5)) * PO + hd * 64 + 2 * (tid & 31) + i * 16 * PO);
        LDS_BARRIER();
        {
            f32x4 bc[4], cc[4]; float cx = dts[0] * xs[p], da = das[0];
#pragma unroll
            for (int i = 0; i < 4; ++i) { bc[i] = *(const LAS f32x4*)(Bs + 4 * nq + 32 * i); cc[i] = *(const LAS f32x4*)(Cs + 4 * nq + 32 * i); }
#pragma unroll 2
            for (int t = 0; t < 64; ++t) {
                const int tn = t < 63 ? t + 1 : 63;
                f32x4 bn[4], cn[4]; const float cxn = dts[tn] * xs[tn * 64 + p], dan = das[tn];
#pragma unroll
                for (int i = 0; i < 4; ++i) { bn[i] = *(const LAS f32x4*)(Bs + tn * 128 + 4 * nq + 32 * i); cn[i] = *(const LAS f32x4*)(Cs + tn * 128 + 4 * nq + 32 * i); }
                f32x2 py = (f32x2){0.f, 0.f};
#pragma unroll
                for (int i = 0; i < 4; ++i) {
                    Hs[2 * i] = Hs[2 * i] * da + (f32x2){bc[i].x, bc[i].y} * cx; Hs[2 * i + 1] = Hs[2 * i + 1] * da + (f32x2){bc[i].z, bc[i].w} * cx;
                    py += Hs[2 * i] * (f32x2){cc[i].x, cc[i].y}; py += Hs[2 * i + 1] * (f32x2){cc[i].z, cc[i].w}; }
                const float y = red8(py.x + py.y);
                if (nq == 0) ys[t * 64 + p] = y;
#pragma unroll
                for (int i = 0; i < 4; ++i) { bc[i] = bn[i]; cc[i] = cn[i]; }
                cx = cxn; da = dan;
            }
        }
        LDS_BARRIER();
#pragma unroll
        for (int i = 0; i < 4; ++i) { const int e = tid + i * NT, t = e >> 5, pp = e & 31; const f32x2 yv = *(const LAS f32x2*)(ys + t * 64 + 2 * pp), xv = *(const LAS f32x2*)(xs + t * 64 + 2 * pp);
            *(unsigned*)(O + (rowb + t0 + t) * D + hd * 64 + 2 * pp) = pk2((yv.x + xv.x * dskip) * silu(bflo(zg[i])), (yv.y + xv.y * dskip) * silu(bfhi(zg[i]))); }
        LDS_BARRIER();
    }
#undef SSD_PREFETCH
}
__device__ __forceinline__ void ssd_fix(bf16* O, const float* w, int gw, int NGW, int lane) {
    f32x4 w0 = *((const f32x4*)w + 2 * lane), w1 = *((const f32x4*)w + 2 * lane + 1);
    for (int m = gw; m < M; m += NGW) {
        v4u* p = (v4u*)(O + (size_t)m * D) + lane; const v4u u = *p;
        float x[8] = {bflo(u.x), bfhi(u.x), bflo(u.y), bfhi(u.y), bflo(u.z), bfhi(u.z), bflo(u.w), bfhi(u.w)};
        float s = 0.f;
#pragma unroll
        for (int j = 0; j < 8; ++j) s += x[j] * x[j];
        s = half_sum(s, lane);
        const float r = frsq(s * (1.f / 256.f) + NORM_EPS);
        v4u o; o.x = pk2(x[0] * r * w0.x, x[1] * r * w0.y); o.y = pk2(x[2] * r * w0.z, x[3] * r * w0.w); o.z = pk2(x[4] * r * w1.x, x[5] * r * w1.y); o.w = pk2(x[6] * r * w1.z, x[7] * r * w1.w);
        *p = o;
    }
}
struct RwkvW { const float *mu, *w0, *w2, *a0, *a2, *g2, *k_k, *k_a, *r_k, *gn_w, *gn_b; };
__device__ __forceinline__ void rwkv_unit(LAS unsigned char* lds, int tid, int lane, int wave, int b, int hd, const bf16* PROJ, bf16* O, const RwkvW W) {
    LAS float* rs = (LAS float*)lds; LAS float* wsd = rs + 2048; LAS float* kks = wsd + 2048; LAS float* vvs = kks + 2048; LAS float* aas = vvs + 2048; LAS float* bbs = aas + 2048;
    LAS float* gs = bbs + 2048; LAS float* ys = gs + 2048;
    LAS bf16* xw = (LAS bf16*)(lds + 65536); LAS bf16* xa = xw + 32 * 72; LAS bf16* xg = xa + 32 * 72;
    LAS bf16* w2t = xg + 32 * 136; LAS bf16* a2t = w2t + 64 * 72; LAS bf16* g2t = a2t + 64 * 72;
    const int vp = tid >> 4, kq = tid & 15;
    f32x2 S0[2], S1[2];
#pragma unroll
    for (int j = 0; j < 2; ++j) { S0[j] = (f32x2){0.f, 0.f}; S1[j] = (f32x2){0.f, 0.f}; }
    const int ch = tid & 63, tg = tid >> 6, cc = hd * 64 + ch;
    const float w0c = W.w0[cc], a0c = W.a0[cc], kkc = W.k_k[cc], kac = W.k_a[cc], rkc = W.r_k[cc], gnw = W.gn_w[cc], gnb = W.gn_b[cc];
    const size_t rowb = (size_t)b * SEQ;
#pragma unroll
    for (int e = tid; e < 4096; e += NT) { const int j = e >> 6, c1 = e & 63; w2t[c1 * 72 + j] = (bf16)f2bf(W.w2[j * 512 + hd * 64 + c1]); a2t[c1 * 72 + j] = (bf16)f2bf(W.a2[j * 512 + hd * 64 + c1]); }
#pragma unroll
    for (int e = tid; e < 8192; e += NT) { const int j = e >> 6, c1 = e & 63; g2t[c1 * 136 + j] = (bf16)f2bf(W.g2[j * 512 + hd * 64 + c1]); }
    const int pp = tid & 255, tq = tid >> 8;
    int dc = 0, kind = 0, loff = 0;
    if (pp < 32) { dc = hd * 64 + 2 * pp; loff = 2 * pp; } else if (pp < 64) { dc = 512 + hd * 64 + 2 * (pp - 32); loff = 2 * (pp - 32); } else if (pp < 96) { dc = 1024 + hd * 64 + 2 * (pp - 64); loff = 2 * (pp - 64); }
    else if (pp < 128) { dc = 1600 + 2 * (pp - 96); loff = 2 * (pp - 96); kind = 2; } else if (pp < 160) { dc = 1536 + 2 * (pp - 128); loff = 2 * (pp - 128); kind = 1; } else if (pp < 224) { dc = 1664 + 2 * (pp - 160); loff = 2 * (pp - 160); kind = 3; }
    LAS float* fdst = pp < 32 ? rs : (pp < 64 ? kks : vvs);
    const float m0 = W.mu[dc], m1 = W.mu[dc + 1];
    const float sB = kind == 1 ? 2.f : 1.f, sC = kind == 1 ? -1.f : 0.f;
    unsigned raw[17];
#define RWKV_PREFETCH(cn) do { if (pp < 224) { const int ts_ = (cn) * 32 + tq * 16; \
        const bf16* pb_ = PROJ + (rowb + ts_) * PO + 1536 + dc; _Pragma("unroll") for (int j = 0; j < 17; ++j) { raw[j] = (j >= 1 || ts_ > 0) ? *(const unsigned*)(pb_ + (j - 1) * PO) : 0u; } } } while (0)
    RWKV_PREFETCH(0);
    const int fr = lane & 15, fq = lane >> 4, mt = wave & 1, mc = wave >> 1;
    for (int c = 0; c < SEQ / 32; ++c) {
        const int t0 = c * 32;
        if (pp < 224) {
            LAS bf16* bdst = kind == 1 ? xw + loff : xg + loff; const int bstr = kind == 1 ? 72 : 136;
#pragma unroll
            for (int i = 0; i < 16; ++i) { const int t = tq * 16 + i;
                float y0 = bflo(raw[i + 1]), y1 = bfhi(raw[i + 1]); y0 += (bflo(raw[i]) - y0) * m0; y1 += (bfhi(raw[i]) - y1) * m1;
                if (kind == 0) *(LAS f32x2*)(fdst + t * 64 + loff) = (f32x2){y0, y1};
                else if (kind == 2) *(LAS unsigned*)(xa + t * 72 + loff) = pk2(y0, y1);
                else *(LAS unsigned*)(bdst + t * bstr) = pk2(sB * sigm(sB * y0) + sC, sB * sigm(sB * y1) + sC); }
        }
        if (c + 1 < SEQ / 32) RWKV_PREFETCH(c + 1);
        LDS_BARRIER();
        {
            f32x4 accw = (f32x4){0.f, 0.f, 0.f, 0.f}, acca = accw, accg = accw;
#pragma unroll
            for (int kk = 0; kk < 2; ++kk) {
                const bf16x8_t xf = *(const LAS bf16x8_t*)(xw + (mt * 16 + fr) * 72 + kk * 32 + 8 * fq), wf = *(const LAS bf16x8_t*)(w2t + (mc * 16 + fr) * 72 + kk * 32 + 8 * fq);
                accw = __builtin_amdgcn_mfma_f32_16x16x32_bf16(wf, xf, accw, 0, 0, 0);
                const bf16x8_t xf2 = *(const LAS bf16x8_t*)(xa + (mt * 16 + fr) * 72 + kk * 32 + 8 * fq), wf2 = *(const LAS bf16x8_t*)(a2t + (mc * 16 + fr) * 72 + kk * 32 + 8 * fq);
                acca = __builtin_amdgcn_mfma_f32_16x16x32_bf16(wf2, xf2, acca, 0, 0, 0); }
#pragma unroll
            for (int kk = 0; kk < 4; ++kk) {
                const bf16x8_t xf = *(const LAS bf16x8_t*)(xg + (mt * 16 + fr) * 136 + kk * 32 + 8 * fq), wf = *(const LAS bf16x8_t*)(g2t + (mc * 16 + fr) * 136 + kk * 32 + 8 * fq);
                accg = __builtin_amdgcn_mfma_f32_16x16x32_bf16(wf, xf, accg, 0, 0, 0); }
            const int o = (mt * 16 + fr) * 64 + mc * 16 + 4 * fq;
            *(LAS f32x4*)(wsd + o) = accw; *(LAS f32x4*)(aas + o) = acca; *(LAS f32x4*)(gs + o) = accg;
        }
        LDS_BARRIER();
#pragma unroll
        for (int i = 0; i < 4; ++i) { const int idx = (tg * 4 + i) * 64 + ch;
            const float wlog = -softplus(-(wsd[idx] + w0c)) - 0.5f, decay = __expf(-__expf(wlog)), a = sigm(aas[idx] + a0c);
            const float kraw = kks[idx], kkv = kraw * kkc; const float kkn = kkv * (frsq(wave_sum(kkv * kkv) + L2_EPS));
            wsd[idx] = decay; kks[idx] = kraw * (1.f + (a - 1.f) * kac); aas[idx] = -kkn; bbs[idx] = kkn * a; }
        LDS_BARRIER();
        {
            const int o = 4 * kq;
            f32x4 ac = *(const LAS f32x4*)(aas + o), wc = *(const LAS f32x4*)(wsd + o), bc = *(const LAS f32x4*)(bbs + o), kc = *(const LAS f32x4*)(kks + o), rc = *(const LAS f32x4*)(rs + o);
            float v0 = vvs[vp], v1 = vvs[vp + 32];
#pragma unroll 2
            for (int t = 0; t < 32; ++t) {
                const int tn = t < 31 ? t + 1 : 31, on = tn * 64 + 4 * kq;
                const f32x4 an = *(const LAS f32x4*)(aas + on), wn = *(const LAS f32x4*)(wsd + on), bn = *(const LAS f32x4*)(bbs + on), kn = *(const LAS f32x4*)(kks + on), rn = *(const LAS f32x4*)(rs + on);
                const float v0n = vvs[tn * 64 + vp], v1n = vvs[tn * 64 + vp + 32];
                const f32x2 alo = (f32x2){ac.x, ac.y}, ahi = (f32x2){ac.z, ac.w}, wlo = (f32x2){wc.x, wc.y}, whi = (f32x2){wc.z, wc.w}, blo = (f32x2){bc.x, bc.y}, bhi = (f32x2){bc.z, bc.w};
                const f32x2 klo = (f32x2){kc.x, kc.y}, khi = (f32x2){kc.z, kc.w}, rlo = (f32x2){rc.x, rc.y}, rhi = (f32x2){rc.z, rc.w};
                const f32x2 p0 = S0[0] * alo + S0[1] * ahi, p1 = S1[0] * alo + S1[1] * ahi;
                const float sa0 = red16(p0.x + p0.y), sa1 = red16(p1.x + p1.y);
                S0[0] = S0[0] * wlo + (blo * sa0 + klo * v0); S0[1] = S0[1] * whi + (bhi * sa0 + khi * v0);
                S1[0] = S1[0] * wlo + (blo * sa1 + klo * v1); S1[1] = S1[1] * whi + (bhi * sa1 + khi * v1);
                const f32x2 q0 = S0[0] * rlo + S0[1] * rhi, q1 = S1[0] * rlo + S1[1] * rhi;
                const float y0 = red16(q0.x + q0.y), y1 = red16(q1.x + q1.y);
                if (kq == 0) { ys[t * 64 + vp] = y0; ys[t * 64 + vp + 32] = y1; }
                ac = an; wc = wn; bc = bn; kc = kn; rc = rn; v0 = v0n; v1 = v1n;
            }
        }
        LDS_BARRIER();
#pragma unroll
        for (int i = 0; i < 4; ++i) { const int t = wave * 4 + i; const int idx = t * 64 + lane; const float y = ys[idx];
            const float mean = wave_sum(y) * (1.f / 64.f), d = y - mean, var = wave_sum(d * d) * (1.f / 64.f);
            const float yn = d * (frsq(var + 64e-5f)) * gnw + gnb;
            const float rk = wave_sum(rs[idx] * kks[idx] * rkc);
            O[(rowb + t0 + t) * D + 512 + hd * 64 + lane] = (bf16)f2bf((yn + rk * vvs[idx]) * gs[idx]); }
        LDS_BARRIER();
    }
#undef RWKV_PREFETCH
}
__device__ __forceinline__ void ssd_chunked(LAS unsigned char* lds, int tid_in, int wave_in, int b, int hd, const bf16* PROJ, const float* SMALL, bf16* O,
                                            const float* convw, const float* convb, float dt_bias, float a_log, float dskip) {
    LAS bf16* Cb = (LAS bf16*)(lds + 0); LAS bf16* CG = (LAS bf16*)(lds + 8704); LAS bf16* Bb = (LAS bf16*)(lds + 17408);
    LAS bf16* BDT = (LAS bf16*)(lds + 26112);
    LAS bf16* XDT = (LAS bf16*)(lds + 36352);
    LAS bf16* ATT = (LAS bf16*)(lds + 41472);
    LAS bf16* ST = (LAS bf16*)(lds + 44032);
    LAS float* YS = (LAS float*)(lds + 61440);
    LAS float* XS = (LAS float*)(lds + 70144);
    LAS float* acs = (LAS float*)(lds + 78336); LAS float* eac = acs + 32; LAS float* dtv = eac + 32; LAS float* ekd = dtv + 32; LAS float* gls = ekd + 32;
    const int g = hd >> 2;
    f32x4 Sacc[4];
#pragma unroll
    for (int j = 0; j < 4; ++j) Sacc[j] = (f32x4){0.f, 0.f, 0.f, 0.f};
    for (int e = tid_in; e < 64 * 136 / 2; e += NT) ((LAS unsigned*)ST)[e] = 0u;
    const int cp0 = tid_in % 160, th0 = tid_in / 160;
    const int xc = cp0 < 32 ? hd * 64 + 2 * cp0 : (cp0 < 96 ? 512 + g * 128 + 2 * (cp0 - 32) : 768 + g * 128 + 2 * (cp0 - 96));
    const int col = 512 + xc;
    float cw[4][2];
#pragma unroll
    for (int j = 0; j < 4; ++j) { cw[j][0] = convw[j * 1024 + xc]; cw[j][1] = convw[j * 1024 + xc + 1]; }
    const float cb0 = convb[xc], cb1 = convb[xc + 1];
    const float Aneg = -__expf(a_log);
    const size_t rowb = (size_t)b * SEQ;
    unsigned raw[19]; float dtr = 0.f;
#define SSD2_PREFETCH(cn) do { const int ts_ = (cn) * 32 + th0 * 16; \
        if (tid_in < 320) { const bf16* pb_ = PROJ + (rowb + ts_) * PO + col; _Pragma("unroll") for (int j = 0; j < 19; ++j) { raw[j] = (j >= 3 || ts_ > 0) ? *(const unsigned*)(pb_ + (j - 3) * PO) : 0u; } } \
        else if (tid_in < 352) dtr = SMALL[(rowb + (cn) * 32 + (tid_in - 320)) * 32 + hd]; } while (0)
    SSD2_PREFETCH(0);
    LDS_BARRIER();
    for (int c = 0; c < SEQ / 32; ++c) {
        int tid_l = tid_in, wave_l = wave_in; asm volatile("" : "+v"(tid_l), "+s"(wave_l));
        const int tid = tid_l, wave = wave_l, lane = tid & 63, fr = lane & 15, fq = lane >> 4, cp = tid % 160, th = tid / 160;
        const int t0 = c * 32;
        float y0[16], y1[16];
        if (tid < 320) {
            f32x2 xv[19];
#pragma unroll
            for (int j = 0; j < 19; ++j) xv[j] = (f32x2){bflo(raw[j]), bfhi(raw[j])};
            const f32x2 c0v = {cw[0][0], cw[0][1]}, c1v = {cw[1][0], cw[1][1]}, c2v = {cw[2][0], cw[2][1]}, c3v = {cw[3][0], cw[3][1]}, cbv = {cb0, cb1};
#pragma unroll
            for (int i = 0; i < 16; ++i) { const f32x2 yv = silu2(((c0v * xv[i] + cbv) + c1v * xv[i + 1]) + (c2v * xv[i + 2] + c3v * xv[i + 3])); y0[i] = yv.x; y1[i] = yv.y; }
        } else if (tid < 384) {
            const float dt = softplus(dtr + dt_bias); float a = dt * Aneg;
#pragma unroll
            for (int o = 1; o < 32; o <<= 1) { const float t_ = __shfl_up(a, o); if ((lane & 31) >= o) a += t_; }
            const float al = __shfl(a, 31);
            if (lane < 32) { acs[lane] = a; eac[lane] = __expf(a); dtv[lane] = dt; ekd[lane] = __expf(al - a); if (lane == 0) gls[0] = __expf(al); }
        }
        if (c + 1 < SEQ / 32) SSD2_PREFETCH(c + 1);
        unsigned zg[2];
#pragma unroll
        for (int i = 0; i < 2; ++i) zg[i] = *(const unsigned*)(PROJ + (rowb + t0 + (tid >> 5)) * PO + hd * 64 + 2 * (tid & 31) + i * 16 * PO);
        LDS_BARRIER();
        if (tid < 320) {
#define SSD2_T16(dst0, dst1) _Pragma("unroll") for (int h8 = 0; h8 < 2; ++h8) { \
                *(LAS v4u*)((dst0) + th * 16 + 8 * h8) = (v4u){pk2(e0[8 * h8], e0[8 * h8 + 1]), pk2(e0[8 * h8 + 2], e0[8 * h8 + 3]), pk2(e0[8 * h8 + 4], e0[8 * h8 + 5]), pk2(e0[8 * h8 + 6], e0[8 * h8 + 7])}; \
                *(LAS v4u*)((dst1) + th * 16 + 8 * h8) = (v4u){pk2(e1[8 * h8], e1[8 * h8 + 1]), pk2(e1[8 * h8 + 2], e1[8 * h8 + 3]), pk2(e1[8 * h8 + 4], e1[8 * h8 + 5]), pk2(e1[8 * h8 + 6], e1[8 * h8 + 7])}; }
            float e0[16], e1[16];
            if (cp < 32) {
#pragma unroll
                for (int i = 0; i < 16; ++i) { const int r = th * 16 + i; const float dt = dtv[r]; *(LAS f32x2*)(XS + r * 64 + 2 * cp) = (f32x2){y0[i], y1[i]}; e0[i] = y0[i] * dt; e1[i] = y1[i] * dt; }
                SSD2_T16(XDT + (2 * cp) * 40, XDT + (2 * cp + 1) * 40)
            } else if (cp < 96) { const int n = 2 * (cp - 32);
#pragma unroll
                for (int i = 0; i < 16; ++i) { const int r = th * 16 + i; const float ek = ekd[r]; *(LAS unsigned*)(Bb + r * 136 + n) = pk2(y0[i], y1[i]); e0[i] = y0[i] * ek; e1[i] = y1[i] * ek; }
                SSD2_T16(BDT + n * 40, BDT + (n + 1) * 40)
            } else { const int n = 2 * (cp - 96);
#pragma unroll
                for (int i = 0; i < 16; ++i) { const int r = th * 16 + i; const float ea = eac[r]; *(LAS unsigned*)(Cb + r * 136 + n) = pk2(y0[i], y1[i]); *(LAS unsigned*)(CG + r * 136 + n) = pk2(y0[i] * ea, y1[i] * ea); }
            }
#undef SSD2_T16
        }
        LDS_BARRIER();
        if (wave < 4) { const int it = wave >> 1, jt = wave & 1; f32x4 acc = (f32x4){0.f, 0.f, 0.f, 0.f};
#pragma unroll
            for (int kk = 0; kk < 4; ++kk) acc = __builtin_amdgcn_mfma_f32_16x16x32_bf16(*(const LAS bf16x8_t*)(Bb + (jt * 16 + fr) * 136 + kk * 32 + 8 * fq), *(const LAS bf16x8_t*)(Cb + (it * 16 + fr) * 136 + kk * 32 + 8 * fq), acc, 0, 0, 0);
            const int i = it * 16 + fr, j0 = jt * 16 + 4 * fq; const float ai = acs[i]; const f32x4 aj = *(const LAS f32x4*)(acs + j0);
            float o4[4];
#pragma unroll
            for (int jj = 0; jj < 4; ++jj) o4[jj] = (j0 + jj <= i) ? acc[jj] * __expf(ai - aj[jj]) : 0.f;
            *(LAS u32x2_t*)(ATT + i * 40 + j0) = (u32x2_t){pk2(o4[0], o4[1]), pk2(o4[2], o4[3])}; }
        LDS_BARRIER();
        {
            const int it = wave & 1, pt = wave >> 1; f32x4 acc = (f32x4){0.f, 0.f, 0.f, 0.f};
#pragma unroll
            for (int kk = 0; kk < 4; ++kk) acc = __builtin_amdgcn_mfma_f32_16x16x32_bf16(*(const LAS bf16x8_t*)(CG + (it * 16 + fr) * 136 + kk * 32 + 8 * fq), *(const LAS bf16x8_t*)(ST + (pt * 16 + fr) * 136 + kk * 32 + 8 * fq), acc, 0, 0, 0);
            acc = __builtin_amdgcn_mfma_f32_16x16x32_bf16(*(const LAS bf16x8_t*)(ATT + (it * 16 + fr) * 40 + 8 * fq), *(const LAS bf16x8_t*)(XDT + (pt * 16 + fr) * 40 + 8 * fq), acc, 0, 0, 0);
#pragma unroll
            for (int jj = 0; jj < 4; ++jj) YS[(it * 16 + 4 * fq + jj) * 68 + pt * 16 + fr] = acc[jj];
            const float gl = gls[0]; const bf16x8_t xb = *(const LAS bf16x8_t*)(BDT + (wave * 16 + fr) * 40 + 8 * fq);
#pragma unroll
            for (int q = 0; q < 4; ++q) Sacc[q] = __builtin_amdgcn_mfma_f32_16x16x32_bf16(xb, *(const LAS bf16x8_t*)(XDT + (q * 16 + fr) * 40 + 8 * fq), Sacc[q] * gl, 0, 0, 0);
        }
        LDS_BARRIER();
#pragma unroll
        for (int q = 0; q < 4; ++q) *(LAS u32x2_t*)(ST + (q * 16 + fr) * 136 + wave * 16 + 4 * fq) = (u32x2_t){pk2(Sacc[q].x, Sacc[q].y), pk2(Sacc[q].z, Sacc[q].w)};
#pragma unroll
        for (int i = 0; i < 2; ++i) { const int t = (tid >> 5) + 16 * i, pp = tid & 31; const f32x2 yv = *(const LAS f32x2*)(YS + t * 68 + 2 * pp), xv = *(const LAS f32x2*)(XS + t * 64 + 2 * pp);
            *(unsigned*)(O + (rowb + t0 + t) * D + hd * 64 + 2 * pp) = pk2((yv.x + xv.x * dskip) * silu(bflo(zg[i])), (yv.y + xv.y * dskip) * silu(bfhi(zg[i]))); }
    }
    LDS_BARRIER();
#undef SSD2_PREFETCH
}
constexpr int RI_GP = 0, RI_HAT = 9216, RI_RT = 18432, RI_RKV = 27648, RI_GG = 35840, RI_WCC = 44032, RI_BYTES = 44288;
__device__ __forceinline__ void rwkv_phase_a(LAS unsigned char* lds, int tid_in, int wave_in, int first, int stride, const bf16* PROJ, bf16* O, unsigned char* RS, const RwkvW W) {
    LAS bf16* w2t = (LAS bf16*)(lds + 0); LAS bf16* a2t = (LAS bf16*)(lds + 9216); LAS bf16* g2t = (LAS bf16*)(lds + 18432);
    LAS float* rs = (LAS float*)(lds + 35840); LAS float* kks = (LAS float*)(lds + 52224); LAS float* vvs = (LAS float*)(lds + 68608);
    LAS bf16* xw = (LAS bf16*)(lds + 84992); LAS bf16* xa = (LAS bf16*)(lds + 94208); LAS bf16* xg = (LAS bf16*)(lds + 103424);
    LAS float* WL = (LAS float*)(lds + 84992); LAS bf16* AL = (LAS bf16*)(lds + 101376); LAS bf16* GL = (LAS bf16*)(lds + 109568);
    LAS float* SEG = (LAS float*)(lds + 120832);
    LAS bf16* AT = (LAS bf16*)(lds + 35840); LAS bf16* BT = (LAS bf16*)(lds + 45056); LAS bf16* KT = (LAS bf16*)(lds + 54272); LAS bf16* RTn = (LAS bf16*)(lds + 63488);
    LAS bf16* BTT = (LAS bf16*)(lds + 72704); LAS bf16* KTT = (LAS bf16*)(lds + 81920); LAS bf16* VTT = (LAS bf16*)(lds + 91136);
    LAS float* Lf = (LAS float*)(lds + 100352); LAS bf16* MAK = (LAS bf16*)(lds + 117760); LAS bf16* NRB = (LAS bf16*)(lds + 126976); LAS bf16* NRK = (LAS bf16*)(lds + 136192);
    LAS float* WCCL = (LAS float*)(lds + 145408);
    LAS float* RHSUT = (LAS float*)(lds + 45056);
    LAS bf16* U0T = (LAS bf16*)(lds + 35840); LAS bf16* WTT = (LAS bf16*)(lds + 45056);
    int cur_hd = -1; float m0 = 0.f, m1 = 0.f;
    unsigned raw[33];
#ifndef RWKVA_NITEMS
#define RWKVA_NITEMS 4096
#endif
#define RWKVA_ITEM(item, c_, hd_, b_) const int c_ = (item) & 31, hd_ = ((item) >> 5) & 7, b_ = ((item) & 4095) >> 8
#define RWKVA_DC(pp_, hd_) ((pp_) < 32 ? (hd_) * 64 + 2 * (pp_) : (pp_) < 64 ? 512 + (hd_) * 64 + 2 * ((pp_) - 32) : (pp_) < 96 ? 1024 + (hd_) * 64 + 2 * ((pp_) - 64) : (pp_) < 128 ? 1600 + 2 * ((pp_) - 96) : (pp_) < 160 ? 1536 + 2 * ((pp_) - 128) : 1664 + 2 * ((pp_) - 160))
#define RWKVA_PREFETCH(item) do { RWKVA_ITEM(item, c__, hd__, b__); const int pp_ = tid_in & 255, tq_ = tid_in >> 8; if (pp_ < 224) { const int ts_ = c__ * 64 + tq_ * 32; \
        const bf16* pb_ = PROJ + ((size_t)b__ * SEQ + ts_) * PO + 1536 + RWKVA_DC(pp_, hd__); _Pragma("unroll") for (int j = 0; j < 33; ++j) { raw[j] = (j >= 1 || ts_ > 0) ? *(const unsigned*)(pb_ + (j - 1) * PO) : 0u; } } } while (0)
    if (first < RWKVA_NITEMS) RWKVA_PREFETCH(first);
    for (int item = first; item < RWKVA_NITEMS; item += stride) {
        int tid_l = tid_in, wave_l = wave_in; asm volatile("" : "+v"(tid_l), "+s"(wave_l));
        const int tid = tid_l, wave = wave_l, lane = tid & 63, fr = lane & 15, fq = lane >> 4;
        RWKVA_ITEM(item, c, hd, b);
        const size_t rowb = (size_t)b * SEQ + c * 64;
        unsigned char* img = RS + (size_t)(item & 4095) * RI_BYTES;
        if (hd != cur_hd) {
            LDS_BARRIER();
#pragma unroll
            for (int e = tid; e < 4096; e += NT) { const int j = e >> 6, c1 = e & 63; w2t[c1 * 72 + j] = (bf16)f2bf(W.w2[j * 512 + hd * 64 + c1]); a2t[c1 * 72 + j] = (bf16)f2bf(W.a2[j * 512 + hd * 64 + c1]); }
#pragma unroll
            for (int e = tid; e < 8192; e += NT) { const int j = e >> 6, c1 = e & 63; g2t[c1 * 136 + j] = (bf16)f2bf(W.g2[j * 512 + hd * 64 + c1]); }
            { const int pp_ = tid & 255; if (pp_ < 224) { const int dc_ = RWKVA_DC(pp_, hd); m0 = W.mu[dc_]; m1 = W.mu[dc_ + 1]; } }
            cur_hd = hd;
        }
        { const int pp = tid & 255, tq = tid >> 8;
          if (pp < 224) {
            const int kind = pp < 96 ? 0 : (pp < 128 ? 2 : (pp < 160 ? 1 : 3));
            const int loff = pp < 32 ? 2 * pp : pp < 64 ? 2 * (pp - 32) : pp < 96 ? 2 * (pp - 64) : pp < 128 ? 2 * (pp - 96) : pp < 160 ? 2 * (pp - 128) : 2 * (pp - 160);
            LAS float* fdst = pp < 32 ? rs : (pp < 64 ? kks : vvs);
            const float sB = kind == 1 ? 2.f : 1.f, sC = kind == 1 ? -1.f : 0.f;
            LAS bf16* bdst = kind == 1 ? xw + loff : xg + loff; const int bstr = kind == 1 ? 72 : 136;
#define RWKVA_MIX(i) const int t = tq * 32 + (i); float y0 = bflo(raw[(i) + 1]), y1 = bfhi(raw[(i) + 1]); y0 += (bflo(raw[(i)]) - y0) * m0; y1 += (bfhi(raw[(i)]) - y1) * m1
            if (kind == 0) {
#pragma unroll
                for (int i = 0; i < 32; ++i) { RWKVA_MIX(i); *(LAS f32x2*)(fdst + t * 64 + loff) = (f32x2){y0, y1}; }
            } else if (kind == 2) {
#pragma unroll
                for (int i = 0; i < 32; ++i) { RWKVA_MIX(i); *(LAS unsigned*)(xa + t * 72 + loff) = pk2(y0, y1); }
            } else {
#pragma unroll
                for (int i = 0; i < 32; ++i) { RWKVA_MIX(i); *(LAS unsigned*)(bdst + t * bstr) = pk2(sB * sigm(sB * y0) + sC, sB * sigm(sB * y1) + sC); }
            }
#undef RWKVA_MIX
          } }
        if (item + stride < RWKVA_NITEMS) RWKVA_PREFETCH(item + stride);
        const int cc = hd * 64 + lane;
        const float w0c = W.w0[cc], a0c = W.a0[cc], kkc = W.k_k[cc], kac = W.k_a[cc], rkc = W.r_k[cc];
        LDS_BARRIER();
        f32x4 rw[2], ra[2], rg[2];
        { const int tt = wave >> 1;
#pragma unroll
          for (int q = 0; q < 2; ++q) { const int ct = (wave & 1) * 2 + q; f32x4 accw = (f32x4){0.f, 0.f, 0.f, 0.f}, acca = accw, accg = accw;
#pragma unroll
            for (int kk = 0; kk < 2; ++kk) {
                accw = __builtin_amdgcn_mfma_f32_16x16x32_bf16(*(const LAS bf16x8_t*)(w2t + (ct * 16 + fr) * 72 + kk * 32 + 8 * fq), *(const LAS bf16x8_t*)(xw + (tt * 16 + fr) * 72 + kk * 32 + 8 * fq), accw, 0, 0, 0);
                acca = __builtin_amdgcn_mfma_f32_16x16x32_bf16(*(const LAS bf16x8_t*)(a2t + (ct * 16 + fr) * 72 + kk * 32 + 8 * fq), *(const LAS bf16x8_t*)(xa + (tt * 16 + fr) * 72 + kk * 32 + 8 * fq), acca, 0, 0, 0); }
#pragma unroll
            for (int kk = 0; kk < 4; ++kk) accg = __builtin_amdgcn_mfma_f32_16x16x32_bf16(*(const LAS bf16x8_t*)(g2t + (ct * 16 + fr) * 136 + kk * 32 + 8 * fq), *(const LAS bf16x8_t*)(xg + (tt * 16 + fr) * 136 + kk * 32 + 8 * fq), accg, 0, 0, 0);
            rw[q] = accw; ra[q] = acca; rg[q] = accg; } }
        LDS_BARRIER();
        { const int tt = wave >> 1;
#pragma unroll
          for (int q = 0; q < 2; ++q) { const int ct = (wave & 1) * 2 + q; const int o = (tt * 16 + fr) * 64 + ct * 16 + 4 * fq;
            *(LAS f32x4*)(WL + o) = rw[q]; *(LAS u32x2_t*)(AL + o) = (u32x2_t){pk2(ra[q].x, ra[q].y), pk2(ra[q].z, ra[q].w)}; const u32x2_t gpk = (u32x2_t){pk2(rg[q].x, rg[q].y), pk2(rg[q].z, rg[q].w)}; *(u32x2_t*)((bf16*)(img + RI_GG) + o) = gpk; } }
        LDS_BARRIER();
        float lw[8], av[8], kn[8], km[8], rr[8], vv[8];
        bf16* prkv = (bf16*)(img + RI_RKV) + wave * 512 + lane;
#pragma unroll
        for (int i = 0; i < 8; ++i) { const int t = wave * 8 + i, idx = t * 64 + lane;
            const float wlog = -softplus(-(WL[idx] + w0c)) - 0.5f; lw[i] = -__expf(wlog);
            const float a = sigm(bflo((unsigned)AL[idx]) + a0c), kraw = kks[idx], kkv = kraw * kkc;
            kn[i] = kkv * frsq(wave_sum(kkv * kkv) + L2_EPS); km[i] = kraw * (1.f + (a - 1.f) * kac); av[i] = a; rr[i] = rs[idx]; vv[i] = vvs[idx];
            const float rk = wave_sum(rr[i] * km[i] * rkc);
            prkv[i * 64] = (bf16)f2bf(rk * vv[i]); }
#pragma unroll
        for (int i = 1; i < 8; ++i) lw[i] += lw[i - 1];
        SEG[wave * 64 + lane] = lw[7];
        LDS_BARRIER();
        { float off = 0.f, tot = 0.f;
#pragma unroll
          for (int w2 = 0; w2 < 8; ++w2) { const float sgm = SEG[w2 * 64 + lane]; tot += sgm; if (w2 < wave) off += sgm; }
          const float wcc = __expf(tot);
          if (wave == 0) { WCCL[lane] = wcc; ((float*)(img + RI_WCC))[lane] = wcc; }
#pragma unroll
          for (int i = 0; i < 8; ++i) { const int t = wave * 8 + i; const float cs = off + lw[i], csx = i ? off + lw[i - 1] : off;
            const float Wc = __expf(cs), Wx = __expf(csx), iW = __expf(-cs);
            const float bbf = kn[i] * av[i] * iW, kbf = km[i] * iW;
            AT[t * 72 + lane] = (bf16)f2bf(-kn[i] * Wx); BT[t * 72 + lane] = (bf16)f2bf(bbf); KT[t * 72 + lane] = (bf16)f2bf(kbf); RTn[t * 72 + lane] = (bf16)f2bf(rr[i] * Wc);
            av[i] = bbf; km[i] = kbf; }
          *(LAS v4u*)(BTT + lane * 72 + wave * 8) = (v4u){pk2(av[0], av[1]), pk2(av[2], av[3]), pk2(av[4], av[5]), pk2(av[6], av[7])};
          *(LAS v4u*)(KTT + lane * 72 + wave * 8) = (v4u){pk2(km[0], km[1]), pk2(km[2], km[3]), pk2(km[4], km[5]), pk2(km[6], km[7])};
          *(LAS v4u*)(VTT + lane * 72 + wave * 8) = (v4u){pk2(vv[0], vv[1]), pk2(vv[2], vv[3]), pk2(vv[4], vv[5]), pk2(vv[6], vv[7])}; }
        LDS_BARRIER();
#if RWKVA_NITEMS > 4096
        if (item >= 4096) continue;
#endif
        { const int tt = wave >> 1, t = tt * 16 + fr;
#pragma unroll
          for (int q = 0; q < 2; ++q) { const int jt = (wave & 1) * 2 + q, j0 = jt * 16 + 4 * fq;
            f32x4 mab = (f32x4){0.f, 0.f, 0.f, 0.f}, mak = mab, nrb = mab, nrk = mab;
            if (jt <= tt) {
#pragma unroll
                for (int kk = 0; kk < 2; ++kk) { const bf16x8_t bx_ = *(const LAS bf16x8_t*)(BT + (jt * 16 + fr) * 72 + kk * 32 + 8 * fq), kx_ = *(const LAS bf16x8_t*)(KT + (jt * 16 + fr) * 72 + kk * 32 + 8 * fq);
                    const bf16x8_t ay_ = *(const LAS bf16x8_t*)(AT + t * 72 + kk * 32 + 8 * fq), ry_ = *(const LAS bf16x8_t*)(RTn + t * 72 + kk * 32 + 8 * fq);
                    mab = __builtin_amdgcn_mfma_f32_16x16x32_bf16(bx_, ay_, mab, 0, 0, 0); mak = __builtin_amdgcn_mfma_f32_16x16x32_bf16(kx_, ay_, mak, 0, 0, 0);
                    nrb = __builtin_amdgcn_mfma_f32_16x16x32_bf16(bx_, ry_, nrb, 0, 0, 0); nrk = __builtin_amdgcn_mfma_f32_16x16x32_bf16(kx_, ry_, nrk, 0, 0, 0); } }
            float l4[4], m4[4], b4[4], k4[4];
#pragma unroll
            for (int jj = 0; jj < 4; ++jj) { const bool lo = (j0 + jj) < t, le = (j0 + jj) <= t; l4[jj] = lo ? -mab[jj] : 0.f; m4[jj] = lo ? mak[jj] : 0.f; b4[jj] = le ? nrb[jj] : 0.f; k4[jj] = le ? nrk[jj] : 0.f; }
            *(LAS f32x4*)(Lf + t * 68 + j0) = (f32x4){l4[0], l4[1], l4[2], l4[3]};
            *(LAS u32x2_t*)(MAK + t * 72 + j0) = (u32x2_t){pk2(m4[0], m4[1]), pk2(m4[2], m4[3])};
            *(LAS u32x2_t*)(NRB + t * 72 + j0) = (u32x2_t){pk2(b4[0], b4[1]), pk2(b4[2], b4[3])};
            *(LAS u32x2_t*)(NRK + t * 72 + j0) = (u32x2_t){pk2(k4[0], k4[1]), pk2(k4[2], k4[3])}; } }
        LDS_BARRIER();
        { const int tt = wave >> 1;
#pragma unroll
          for (int q = 0; q < 2; ++q) { const int vt = (wave & 1) * 2 + q; f32x4 acc = (f32x4){0.f, 0.f, 0.f, 0.f};
#pragma unroll
            for (int kk = 0; kk < 2; ++kk) acc = __builtin_amdgcn_mfma_f32_16x16x32_bf16(*(const LAS bf16x8_t*)(MAK + (tt * 16 + fr) * 72 + kk * 32 + 8 * fq), *(const LAS bf16x8_t*)(VTT + (vt * 16 + fr) * 72 + kk * 32 + 8 * fq), acc, 0, 0, 0);
            *(LAS f32x4*)(RHSUT + (vt * 16 + fr) * 68 + tt * 16 + 4 * fq) = acc; } }
        LDS_BARRIER();
        f32x2 us2[32];
        if (tid < 64) {
#pragma unroll
            for (int m = 0; m < 16; ++m) { const f32x4 r4 = *(const LAS f32x4*)(RHSUT + tid * 68 + 4 * m); us2[2 * m] = (f32x2){r4.x, r4.y}; us2[2 * m + 1] = (f32x2){r4.z, r4.w}; }
        } else if (tid < 128) {
#pragma unroll
            for (int m = 0; m < 32; ++m) us2[m] = (f32x2){bflo((unsigned)AT[(2 * m) * 72 + tid - 64]), bflo((unsigned)AT[(2 * m + 1) * 72 + tid - 64])};
        }
        LDS_BARRIER();
        if (tid < 128) {
            const LAS float* Lfv = Lf; asm volatile("" : "+v"(Lfv));
#pragma unroll
            for (int i = 1; i < 64; ++i) { f32x2 a0 = (f32x2){0.f, 0.f}, a1 = (f32x2){0.f, 0.f}; if (i & 1) __builtin_amdgcn_sched_barrier(0);
#pragma unroll
                for (int j4 = 0; j4 < 16; ++j4) if (4 * j4 < i) { const f32x4 l4 = *(const LAS f32x4*)(Lfv + i * 68 + 4 * j4); a0 += (f32x2){l4.x, l4.y} * us2[2 * j4]; a1 += (f32x2){l4.z, l4.w} * us2[2 * j4 + 1]; }
                const float sub = (a0.x + a0.y) + (a1.x + a1.y);
                if (i & 1) us2[i >> 1].y -= sub; else us2[i >> 1].x -= sub; }
            LAS bf16* dstp = tid < 64 ? U0T + tid * 72 : WTT + (tid - 64) * 72;
#pragma unroll
            for (int m = 0; m < 32; m += 4) *(LAS v4u*)(dstp + 2 * m) = (v4u){pk2(us2[m].x, us2[m].y), pk2(us2[m + 1].x, us2[m + 1].y), pk2(us2[m + 2].x, us2[m + 2].y), pk2(us2[m + 3].x, us2[m + 3].y)};
        }
        LDS_BARRIER();
        { const int rt = wave >> 1, rowl = rt * 16 + fr;
#pragma unroll
          for (int q = 0; q < 2; ++q) { const int ct = (wave & 1) * 2 + q, c0 = ct * 16 + 4 * fq;
            f32x4 a1 = (f32x4){0.f, 0.f, 0.f, 0.f}, a2 = a1, a3 = a1, a4 = a1;
#pragma unroll
            for (int kk = 0; kk < 2; ++kk) { const int ko = kk * 32 + 8 * fq;
                const bf16x8_t wtt_c = *(const LAS bf16x8_t*)(WTT + (ct * 16 + fr) * 72 + ko), u0t_c = *(const LAS bf16x8_t*)(U0T + (ct * 16 + fr) * 72 + ko), vtt_c = *(const LAS bf16x8_t*)(VTT + (ct * 16 + fr) * 72 + ko);
                const bf16x8_t btt_c = *(const LAS bf16x8_t*)(BTT + (ct * 16 + fr) * 72 + ko), ktt_c = *(const LAS bf16x8_t*)(KTT + (ct * 16 + fr) * 72 + ko);
                const bf16x8_t nrb_r = *(const LAS bf16x8_t*)(NRB + rowl * 72 + ko), nrk_r = *(const LAS bf16x8_t*)(NRK + rowl * 72 + ko);
                const bf16x8_t btt_r = *(const LAS bf16x8_t*)(BTT + rowl * 72 + ko), u0t_r = *(const LAS bf16x8_t*)(U0T + rowl * 72 + ko), vtt_r = *(const LAS bf16x8_t*)(VTT + rowl * 72 + ko);
                a1 = __builtin_amdgcn_mfma_f32_16x16x32_bf16(wtt_c, nrb_r, a1, 0, 0, 0);
                a2 = __builtin_amdgcn_mfma_f32_16x16x32_bf16(u0t_c, nrb_r, a2, 0, 0, 0); a2 = __builtin_amdgcn_mfma_f32_16x16x32_bf16(vtt_c, nrk_r, a2, 0, 0, 0);
                a3 = __builtin_amdgcn_mfma_f32_16x16x32_bf16(wtt_c, btt_r, a3, 0, 0, 0);
                a4 = __builtin_amdgcn_mfma_f32_16x16x32_bf16(btt_c, u0t_r, a4, 0, 0, 0); a4 = __builtin_amdgcn_mfma_f32_16x16x32_bf16(ktt_c, vtt_r, a4, 0, 0, 0); }
            const u32x2_t rn = *(const LAS u32x2_t*)(RTn + rowl * 72 + c0);
            a1 += (f32x4){bflo(rn.x), bfhi(rn.x), bflo(rn.y), bfhi(rn.y)};
            *(u32x2_t*)((bf16*)(img + RI_RT) + rowl * 72 + c0) = (u32x2_t){pk2(a1.x, a1.y), pk2(a1.z, a1.w)};
            *(u32x2_t*)(O + (rowb + rowl) * D + 512 + hd * 64 + c0) = (u32x2_t){pk2(a2.x, a2.y), pk2(a2.z, a2.w)};
            a3 = a3 * WCCL[rowl];
            *(u32x2_t*)((bf16*)(img + RI_GP) + rowl * 72 + c0) = (u32x2_t){pk2(a3.x, a3.y), pk2(a3.z, a3.w)};
            a4 = a4 * *(const LAS f32x4*)(WCCL + c0);
            *(u32x2_t*)((bf16*)(img + RI_HAT) + rowl * 72 + c0) = (u32x2_t){pk2(a4.x, a4.y), pk2(a4.z, a4.w)}; } }
        LDS_BARRIER();
    }
#undef RWKVA_PREFETCH
#undef RWKVA_DC
#undef RWKVA_ITEM
}
__device__ __forceinline__ void rwkv_phase_b(LAS unsigned char* lds, int tid_in, int wave_in, int b, int hd, const unsigned char* RS, bf16* O, const float* gn_w, const float* gn_b) {
    LAS bf16* GP = (LAS bf16*)(lds + RI_GP); LAS bf16* HAT = (LAS bf16*)(lds + RI_HAT); LAS bf16* RT = (LAS bf16*)(lds + RI_RT); LAS bf16* RKV = (LAS bf16*)(lds + RI_RKV); LAS bf16* GG = (LAS bf16*)(lds + RI_GG);
    LAS float* WCC = (LAS float*)(lds + RI_WCC); LAS bf16* HT = (LAS bf16*)(lds + 44288); LAS float* YS = (LAS float*)(lds + 53504);
    f32x4 Hacc[2];
    Hacc[0] = (f32x4){0.f, 0.f, 0.f, 0.f}; Hacc[1] = Hacc[0];
    for (int e = tid_in; e < 64 * 72 / 2; e += NT) ((LAS unsigned*)HT)[e] = 0u;
    const float gnw = gn_w[hd * 64 + (tid_in & 63)], gnb = gn_b[hd * 64 + (tid_in & 63)];
    const size_t rowb = (size_t)b * SEQ;
    const unsigned char* rsb = RS + (size_t)((b * 8 + hd) * 32) * RI_BYTES;
    v4u ring[4][6]; u32x2_t yring[4][2];
#define RWKVB_PREFETCH(cn, st) do { const v4u* src_ = (const v4u*)(rsb + (size_t)(cn) * RI_BYTES); _Pragma("unroll") for (int k = 0; k < 6; ++k) { const int e = tid_in + k * NT; if (e < RI_BYTES / 16) ring[st][k] = src_[e]; } \
        { const int l_ = tid_in & 63, w_ = tid_in >> 6; _Pragma("unroll") for (int q = 0; q < 2; ++q) yring[st][q] = *(const u32x2_t*)(O + (rowb + (cn) * 64 + (w_ >> 1) * 16 + (l_ & 15)) * D + 512 + hd * 64 + ((w_ & 1) * 2 + q) * 16 + 4 * (l_ >> 4)); } } while (0)
    RWKVB_PREFETCH(0, 0); RWKVB_PREFETCH(1, 1); RWKVB_PREFETCH(2, 2); RWKVB_PREFETCH(3, 3);
    LDS_BARRIER();
    for (int c0 = 0; c0 < SEQ / 64; c0 += 4) {
#pragma unroll
      for (int st = 0; st < 4; ++st) { const int c = c0 + st;
        int tid_l = tid_in, wave_l = wave_in; asm volatile("" : "+v"(tid_l), "+s"(wave_l));
        const int tid = tid_l, wave = wave_l, lane = tid & 63, fr = lane & 15, fq = lane >> 4;
#pragma unroll
        for (int k = 0; k < 6; ++k) { const int e = tid + k * NT; if (e < RI_BYTES / 16) *(LAS v4u*)(lds + e * 16) = ring[st][k]; }
        const u32x2_t yc0 = yring[st][0], yc1 = yring[st][1];
        if (c + 4 < SEQ / 64) RWKVB_PREFETCH(c + 4, st);
        LDS_BARRIER();
        { const int tt = wave >> 1;
#pragma unroll
          for (int q = 0; q < 2; ++q) { const int vt = (wave & 1) * 2 + q; f32x4 acc = (f32x4){0.f, 0.f, 0.f, 0.f};
#pragma unroll
            for (int kk = 0; kk < 2; ++kk) acc = __builtin_amdgcn_mfma_f32_16x16x32_bf16(*(const LAS bf16x8_t*)(HT + (vt * 16 + fr) * 72 + kk * 32 + 8 * fq), *(const LAS bf16x8_t*)(RT + (tt * 16 + fr) * 72 + kk * 32 + 8 * fq), acc, 0, 0, 0);
            const u32x2_t yy = q ? yc1 : yc0;
            acc += (f32x4){bflo(yy.x), bfhi(yy.x), bflo(yy.y), bfhi(yy.y)};
            *(LAS f32x4*)(YS + (tt * 16 + fr) * 68 + vt * 16 + 4 * fq) = acc; }
          const int kt = wave >> 1; const f32x4 wc4 = *(const LAS f32x4*)(WCC + kt * 16 + 4 * fq);
#pragma unroll
          for (int q = 0; q < 2; ++q) { const int vt = (wave & 1) * 2 + q; f32x4 acc = Hacc[q] * wc4;
#pragma unroll
            for (int kk = 0; kk < 2; ++kk) acc = __builtin_amdgcn_mfma_f32_16x16x32_bf16(*(const LAS bf16x8_t*)(GP + (kt * 16 + fr) * 72 + kk * 32 + 8 * fq), *(const LAS bf16x8_t*)(HT + (vt * 16 + fr) * 72 + kk * 32 + 8 * fq), acc, 0, 0, 0);
            const u32x2_t ha = *(const LAS u32x2_t*)(HAT + (vt * 16 + fr) * 72 + kt * 16 + 4 * fq);
            Hacc[q] = acc + (f32x4){bflo(ha.x), bfhi(ha.x), bflo(ha.y), bfhi(ha.y)}; } }
        LDS_BARRIER();
        { const int kt = wave >> 1;
#pragma unroll
          for (int q = 0; q < 2; ++q) { const int vt = (wave & 1) * 2 + q; *(LAS u32x2_t*)(HT + (vt * 16 + fr) * 72 + kt * 16 + 4 * fq) = (u32x2_t){pk2(Hacc[q].x, Hacc[q].y), pk2(Hacc[q].z, Hacc[q].w)}; } }
#pragma unroll
        for (int i = 0; i < 8; ++i) { const int t = wave * 8 + i; const float y = YS[t * 68 + lane];
            const float mean = wave_sum(y) * (1.f / 64.f), d = y - mean, var = wave_sum(d * d) * (1.f / 64.f);
            const float yn = d * frsq(var + 64e-5f) * gnw + gnb;
            O[(rowb + c * 64 + t) * D + 512 + hd * 64 + lane] = (bf16)f2bf((yn + bflo((unsigned)RKV[t * 64 + lane])) * bflo((unsigned)GG[t * 64 + lane])); }
        LDS_BARRIER();
      }
    }
#undef RWKVB_PREFETCH
}
#ifndef REP_EVEN
#define REP_EVEN 1
#endif
#ifndef REP_ODD
#define REP_ODD 1
#endif
#ifndef ODD2_UNITS
#define ODD2_UNITS 256
#endif
#ifndef REP_GEMM
#define REP_GEMM 1
#endif
#ifndef REP_EVENB
#define REP_EVENB 1
#endif
#ifndef REP_MASK
#define REP_MASK 3
#endif
struct Args { const float* in[34]; float* out; unsigned char* ws; int lo, hi; };
__global__ void __launch_bounds__(NT, 2) trunk_fwd(Args args) {
    extern __shared__ __attribute__((aligned(16))) unsigned char lds_raw[];
    LAS unsigned char* lds = (LAS unsigned char*)lds_raw;
    const int G = gridDim.x, bx = blockIdx.x, NGW = G * NWAVES, NGT = G * NT;
#define KARGS() const __attribute__((address_space(4))) Args* KA = (const __attribute__((address_space(4))) Args*)__builtin_amdgcn_kernarg_segment_ptr(); asm volatile("" : "+s"(KA))
#define FRESH() KARGS(); int tid = threadIdx.x; asm volatile("" : "+v"(tid)); const int lane = tid & 63, wave = __builtin_amdgcn_readfirstlane(tid >> 6); const int gw = bx * NWAVES + wave, gt = bx * NT + tid; (void)gt; (void)gw; (void)lane
    unsigned char* ws = args.ws;
    bf16* XN = (bf16*)(ws + WS_XN); float* SMALL = (float*)(ws + WS_SMALL); bf16* PROJ = (bf16*)(ws + WS_PROJ); bf16* HB = PROJ;
    float* out = args.out; bf16* HN = (bf16*)(ws + WS_HN); float* SSQ = (float*)(ws + WS_SSQ);
    const int lo = args.lo, hi = args.hi;
    int ph = 0;
#if MK_COOP
    cg::grid_group grid = cg::this_grid();
    volatile LAS unsigned* MISC = (volatile LAS unsigned*)(lds + MISC_OFF);
    if (threadIdx.x < 64) MISC[threadIdx.x] = 0u;
    __syncthreads();
    const XcdBarrier xbar = xcd_barrier_post((unsigned*)(ws + WS_CTL) + CW_BAR, MISC + 8);
#define SEAM() do { xcd_barrier(xbar); } while (0)
    if (args.lo == 0x7fffffff) grid.sync();
#define IN_PHASE (true)
#else
#define SEAM() do { ++ph; } while (0)
#define IN_PHASE (ph >= lo && ph < hi)
#endif

    if (IN_PHASE) {
        FRESH();
        LAS float* scr = (LAS float*)(lds + wave * 16384);
#pragma unroll 1
        for (int L = 0; L < DEPTH; ++L) {
            const int i = L >> 1; unsigned char* wl = ws + WS_W + (size_t)L * W_LAYER;
            if ((L & 1) == 0) { const float* W = KA->in[6] + (size_t)i * D * EVEN_IN;
                transpose_matrix(W, EVEN_IN, D, (bf16*)(wl + W_IN), PE, 2048, scr, gw, NGW, lane, KA->in[1] + L * D); tail_rows(W, EVEN_IN, (bf16*)(wl + W_IN), PE, NE, true, gt, NGT, KA->in[1] + L * D);
                transpose_matrix(KA->in[14] + (size_t)i * D * D, D, D, (bf16*)(wl + W_OUT), D, 1 << 30, scr, gw, NGW, lane, nullptr);
            } else { const float* W = KA->in[15] + (size_t)i * D * ODD_IN;
                transpose_matrix(W, ODD_IN, D, (bf16*)(wl + W_IN), PO, 1536, scr, gw, NGW, lane, KA->in[1] + L * D); tail_rows(W, ODD_IN, (bf16*)(wl + W_IN), PO, NO, false, gt, NGT, KA->in[1] + L * D);
                transpose_matrix(KA->in[33] + (size_t)i * D * D, D, D, (bf16*)(wl + W_OUT), D, 1 << 30, scr, gw, NGW, lane, nullptr);
            }
        }
        copy_rows_bf16_ssq(KA->in[0], HN, SSQ, gw, NGW, lane);
    }
    SEAM();
#pragma unroll 1
    for (int L = 0; L < DEPTH; ++L) {
        const int i = L >> 1; const bool even = (L & 1) == 0;
        unsigned char* wl = ws + WS_W + (size_t)L * W_LAYER;
        if (IN_PHASE) {
            const int Np = even ? NE : NO;
            pg8::Gemm g{HN, (const bf16*)(wl + W_IN), M, Np, D}; pg8::StaticOrder S; S.init(M, Np, G, bx);
            pg8::EpiProj E{PROJ, even ? PE : PO, (even ? PE : PO) / 256, SMALL, SSQ, (LAS float*)(lds + RSTD_OFF)};
            for (int rg = 0; rg < REP_GEMM; ++rg) pg8::gemm_phase<pg8::EpiProj, pg8::StaticOrder, true, true>(lds, g, S, E);
        }
        SEAM();
        if (IN_PHASE) {
            FRESH();
#ifndef NO_EVEN
            if (even) {
                for (int rep = 0; rep < REP_EVEN; ++rep) {
                int tl = tid; asm volatile("" : "+v"(tl)); const int ll = tl & 63;
                if (rep == 0 || (REP_MASK & 1)) gdn_phase_a(lds, tl, wave, bx, G, PROJ, SMALL, ws + WS_GS, KA->in[7] + (size_t)i * 4 * 1536, KA->in[8] + i * 4, KA->in[9] + i * 4);
                }
            }
#endif
#ifndef NO_ODD
            if (!even) {
                RwkvW W{KA->in[22] + i * 1792, KA->in[23] + i * 512, KA->in[24] + (size_t)i * 64 * 512, KA->in[25] + i * 512, KA->in[26] + (size_t)i * 64 * 512, KA->in[27] + (size_t)i * 128 * 512,
                        KA->in[28] + i * 512, KA->in[29] + i * 512, KA->in[30] + i * 512, KA->in[31] + i * 512, KA->in[32] + i * 512};
                for (int rep = 0; rep < REP_ODD; ++rep) { int tl = tid; asm volatile("" : "+v"(tl)); rwkv_phase_a(lds, tl, wave, bx, G, PROJ, XN, ws + WS_RS, W); }
            }
#endif
        }
        SEAM();
        if (even) { if (IN_PHASE) { FRESH(); for (int rep = 0; rep < REP_EVENB; ++rep) { int tl = tid; asm volatile("" : "+v"(tl)); if (bx < 64) gdn_phase_b(lds, tl, wave, bx >> 2, bx & 3, PROJ, ws + WS_GS, XN, KA->in[10] + i * 128);
                else if (bx < 128) gla_chunked(lds, tl, wave, (bx - 64) >> 2, bx & 3, PROJ, SMALL, XN, KA->in[11] + (size_t)i * 16 * 256, KA->in[12] + i * 256, KA->in[13] + i * 128);
                else if (rep == 0) { LAS float* scr = (LAS float*)(lds + wave * 16384); transpose_matrix(KA->in[3] + (size_t)L * D * FF, FF, D, (bf16*)(ws + WS_WMLP + W_1), FF, 1 << 30, scr, ((bx - 128) * NWAVES + wave), ((G - 128) * NWAVES), lane, KA->in[2] + L * D); transpose_matrix(KA->in[4] + (size_t)L * FF * D, D, FF, (bf16*)(ws + WS_WMLP + W_2), D, 1 << 30, scr, ((bx - 128) * NWAVES + wave), ((G - 128) * NWAVES), lane, nullptr); } } } SEAM(); }
        if (!even) { if (IN_PHASE) { FRESH();
            for (int uu = bx; uu < ODD2_UNITS; uu += G) { const int u = uu & 255; const int b = (u & 127) >> 3, hd = u & 7; int tl = tid; asm volatile("" : "+v"(tl));
                if (u < 128) ssd_chunked(lds, tl, wave, b, hd, PROJ, SMALL, XN, KA->in[16] + (size_t)i * 4 * 1024, KA->in[17] + i * 1024, KA->in[18][i * 8 + hd], KA->in[19][i * 8 + hd], KA->in[20][i * 8 + hd]);
                else rwkv_phase_b(lds, tl, wave, b, hd, ws + WS_RS, XN, KA->in[31] + i * 512, KA->in[32] + i * 512); }
            if (bx < 128) { LAS float* scr = (LAS float*)(lds + wave * 16384); transpose_matrix(KA->in[3] + (size_t)L * D * FF, FF, D, (bf16*)(ws + WS_WMLP + W_1), FF, 1 << 30, scr, (bx * NWAVES + wave), (128 * NWAVES), lane, KA->in[2] + L * D); transpose_matrix(KA->in[4] + (size_t)L * FF * D, D, FF, (bf16*)(ws + WS_WMLP + W_2), D, 1 << 30, scr, (bx * NWAVES + wave), (128 * NWAVES), lane, nullptr); }
        } SEAM(); }
        if (!even) { if (IN_PHASE) { FRESH(); ssd_fix(XN, KA->in[21] + i * 512, gw, NGW, lane); } SEAM(); }
        if (IN_PHASE) {
            KARGS();
            pg8::Gemm g{XN, (const bf16*)(wl + W_OUT), M, D, D}; pg8::StaticOrder S; S.init(M, D, G, bx);
            pg8::EpiRes E{L == 0 ? KA->in[0] : out, out, D, HN, SSQ};
            pg8::gemm_phase<pg8::EpiRes, pg8::StaticOrder, true, true>(lds, g, S, E);
        }
        SEAM();
        if (IN_PHASE) {
            pg8::Gemm g{HN, (const bf16*)(ws + WS_WMLP + W_1), M, FF, D}; pg8::StaticOrder S; S.init(M, FF, G, bx);
            pg8::EpiSq E{HB, FF, SSQ, (LAS float*)(lds + RSTD_OFF)};
            for (int rg = 0; rg < REP_GEMM; ++rg) pg8::gemm_phase<pg8::EpiSq, pg8::StaticOrder, true, true>(lds, g, S, E);
        }
        SEAM();
        if (IN_PHASE) {
            pg8::Gemm g{HB, (const bf16*)(ws + WS_WMLP + W_2), M, D, FF}; pg8::StaticOrder S; S.init(M, D, G, bx);
            pg8::EpiRes E{out, out, D, HN, SSQ};
            pg8::gemm_phase<pg8::EpiRes, pg8::StaticOrder, true, true>(lds, g, S, E);
        }
        SEAM();
        if (L + 1 == DEPTH) { if (IN_PHASE) { FRESH(); norm_rows_f32(out, KA->in[5], gw, NGW, lane); } }
    }
#undef SEAM
#undef IN_PHASE
}
constexpr int N_PHASES = 1 + DEPTH * 8;

extern "C" void kernel_launch(void* const* d_in, const int* in_sizes, int n_in, void* d_out, int out_size, void* d_ws, size_t ws_size, hipStream_t stream) {
    static int grid = 0;
    if (grid == 0) {
        if (n_in != 34 || in_sizes[0] != M * D || out_size != M * D || ws_size < WS_END) { fprintf(stderr, "kernel_launch: unexpected shapes (n_in %d, in0 %d, out %d, ws %zu); nothing launched\n", n_in, n_in > 0 ? in_sizes[0] : -1, out_size, ws_size); grid = -1; return; }
        int dev = 0, cus = 0, per_cu = 0;
        if (hipGetDevice(&dev) != hipSuccess || hipDeviceGetAttribute(&cus, hipDeviceAttributeMultiprocessorCount, dev) != hipSuccess) { grid = -1; return; }
        if (hipFuncSetAttribute((const void*)trunk_fwd, hipFuncAttributeMaxDynamicSharedMemorySize, LDS_BYTES) != hipSuccess) { fprintf(stderr, "kernel_launch: hipFuncSetAttribute failed\n"); grid = -1; return; }
        if (hipOccupancyMaxActiveBlocksPerMultiprocessor(&per_cu, (const void*)trunk_fwd, NT, LDS_BYTES) != hipSuccess || per_cu < 1) { fprintf(stderr, "kernel_launch: occupancy query says %d\n", per_cu); per_cu = 1; }
        (void)hipGetLastError();
        grid = cus * 1;
    }
    if (grid < 0) return;
    if (hipMemsetAsync((char*)d_ws + WS_CTL, 0, CTL_ZERO_BYTES, stream) != hipSuccess) { fprintf(stderr, "kernel_launch: memset failed\n"); return; }
    Args a{};
    for (int i = 0; i < 34; ++i) a.in[i] = (const float*)d_in[i];
    a.out = (float*)d_out; a.ws = (unsigned char*)d_ws;
#if MK_COOP
    a.lo = 0; a.hi = N_PHASES;
    void* kargs[] = {&a};
    hipError_t e = hipLaunchCooperativeKernel((const void*)trunk_fwd, dim3(grid), dim3(NT), kargs, LDS_BYTES, stream);
    if (e != hipSuccess) fprintf(stderr, "kernel_launch: cooperative launch failed: %s (grid %d)\n", hipGetErrorString(e), grid);
#else
    for (int p = 0; p < N_PHASES; ++p) { a.lo = p; a.hi = p + 1; hipLaunchKernelGGL(trunk_fwd, dim3(grid), dim3(NT), LDS_BYTES, stream, a); }
#endif
}
```

```cpp
#include <hip/hip_runtime.h>
#include <hip/hip_cooperative_groups.h>
#include <cstdio>
#include <cstdint>
namespace cg = cooperative_groups;
#ifndef MK_COOP
#define MK_COOP 1
#endif
namespace pg8 {
#define PG8_LAS __attribute__((address_space(3)))
typedef unsigned short bf16_t;
typedef short bf16x8 __attribute__((ext_vector_type(8)));
typedef float f32x4 __attribute__((ext_vector_type(4)));
typedef unsigned u32x4 __attribute__((ext_vector_type(4)));
constexpr int BM = 256, BK = 64, HALF = 128, HTB = HALF * BK * 2  , STAGE_BYTES = 8 * HTB, NXCD = 8, WGM = 8;

__host__ __device__ __forceinline__ int lds_byte(int r, int c) { const int st = (r >> 4) * 2 + (c >> 5), rr = r & 15, cc = c & 31, ob = rr * 64 + cc * 2; return st * 1024 + (ob ^ (((ob >> 9) & 1) << 5)); }
__host__ __device__ __forceinline__ void stage_rc(int b, int& R, int& C) { const int st = b / 1024, sb = b % 1024, swz = sb ^ (((sb >> 9) & 1) << 5); R = (st >> 1) * 16 + swz / 64; C = (st & 1) * 32 + (swz % 64) / 2; }
__host__ __device__ __forceinline__ int perm32(int rho) { const int n = rho >> 4, i = rho & 15; return 8 * (i >> 2) + 4 * n + (i & 3); }

struct Unit { int pm, pn; };
struct Gemm { const bf16_t* A; const bf16_t* Bt; int M, N, K; };

struct StaticOrder {
    int nM, nN, nwg, G, c;
    __host__ __device__ void init(int M, int N, int G_, int c_) { nM = M / BM; nN = N / BM; nwg = nM * nN; G = G_; c = c_; }
    __host__ __device__ bool next(int i, Unit& u) const {
        const long L = (long)i * G + c; if (L >= nwg) return false;
        int wgid = (int)L; { const int q = nwg / NXCD, r = nwg % NXCD, xcd = wgid % NXCD, off = wgid / NXCD; wgid = (xcd < r ? xcd * (q + 1) : r * (q + 1) + (xcd - r) * q) + off; }
        const int nig = WGM * nN, gid = wgid / nig, fm = gid * WGM, gsz = (nM - fm) < WGM ? (nM - fm) : WGM;
        u.pm = fm + ((wgid % nig) % gsz); u.pn = (wgid % nig) / gsz; return true;
    }
    __device__ __forceinline__ void a_ready(const Unit&) const {}
    __device__ __forceinline__ void done(const Unit&) const {}
};

__device__ __forceinline__ unsigned cvt_pk_bf16(float lo, float hi) { unsigned r; asm volatile("v_cvt_pk_bf16_f32 %0, %1, %2" : "=v"(r) : "v"(lo), "v"(hi)); return r; }
__device__ __forceinline__ void rstd_table(const float* ssq, int pm, PG8_LAS float* tab) {
    int t = threadIdx.x; asm volatile("" : "+v"(t));
    const f32x4* p = (const f32x4*)(ssq + ((size_t)pm * BM + (t >> 1)) * 16 + (t & 1) * 8); const f32x4 a = p[0] + p[1];
    float s = (a.x + a.y) + (a.z + a.w);
    s += __builtin_bit_cast(float, __builtin_amdgcn_mov_dpp(__builtin_bit_cast(int, s), 0xB1, 0xf, 0xf, true));
    if ((t & 1) == 0) tab[t >> 1] = __builtin_amdgcn_rsqf(s * (1.f / 1024.f) + 1e-6f);
    asm volatile("s_waitcnt lgkmcnt(0)" ::: "memory"); __builtin_amdgcn_s_barrier(); asm volatile("" ::: "memory");
}
struct EpiProj {
    static constexpr bool PERM = true, AFTER_DRAIN = false;
    bf16_t* O; int ldc; int n_main; float* small; const float* ssq; PG8_LAS float* tab;
    __device__ __forceinline__ void operator()(const f32x4 (&acc)[2][2][4][2], const Unit& u, int wr, int wc, int fr, int fq) const {
        rstd_table(ssq, u.pm, tab);
        const int row0 = u.pm * BM + wr * 64 + fr;
        if (u.pn < n_main) {
            const int col0 = u.pn * BM + wc * 32 + 8 * fq;
#pragma unroll
            for (int ai = 0; ai < 2; ++ai)
#pragma unroll
                for (int m = 0; m < 4; ++m) { bf16_t* rowp = O + (size_t)(row0 + ai * HALF + m * 16) * ldc + col0; const float rs = tab[wr * 64 + fr + ai * HALF + m * 16];
#pragma unroll
                    for (int bj = 0; bj < 2; ++bj) { const f32x4 v0 = acc[ai][bj][m][0] * rs, v1 = acc[ai][bj][m][1] * rs;
                        u32x4 w; w.x = cvt_pk_bf16(v0[0], v0[1]); w.y = cvt_pk_bf16(v0[2], v0[3]); w.z = cvt_pk_bf16(v1[0], v1[1]); w.w = cvt_pk_bf16(v1[2], v1[3]);
                        *(u32x4*)(rowp + bj * HALF) = w; } }
        } else if (wc == 0) {
#pragma unroll
            for (int ai = 0; ai < 2; ++ai)
#pragma unroll
                for (int m = 0; m < 4; ++m) { float* rp = small + (size_t)(row0 + ai * HALF + m * 16) * 32 + 8 * fq; const float rs = tab[wr * 64 + fr + ai * HALF + m * 16];
                    *(f32x4*)rp = acc[ai][0][m][0] * rs; *(f32x4*)(rp + 4) = acc[ai][0][m][1] * rs; }
        }
    }
};
struct EpiSq {
    static constexpr bool PERM = true, AFTER_DRAIN = false;
    bf16_t* O; int ldc; const float* ssq; PG8_LAS float* tab;
    __device__ __forceinline__ void operator()(const f32x4 (&acc)[2][2][4][2], const Unit& u, int wr, int wc, int fr, int fq) const {
        rstd_table(ssq, u.pm, tab);
        const int row0 = u.pm * BM + wr * 64 + fr, col0 = u.pn * BM + wc * 32 + 8 * fq;
#pragma unroll
        for (int ai = 0; ai < 2; ++ai)
#pragma unroll
            for (int m = 0; m < 4; ++m) { bf16_t* rowp = O + (size_t)(row0 + ai * HALF + m * 16) * ldc + col0; const float rs = tab[wr * 64 + fr + ai * HALF + m * 16];
#pragma unroll
                for (int bj = 0; bj < 2; ++bj) { f32x4 v0 = acc[ai][bj][m][0] * rs, v1 = acc[ai][bj][m][1] * rs;
#pragma unroll
                    for (int j = 0; j < 4; ++j) { const float a = fmaxf(v0[j], 0.f), b = fmaxf(v1[j], 0.f); v0[j] = a * a; v1[j] = b * b; }
                    u32x4 w; w.x = cvt_pk_bf16(v0[0], v0[1]); w.y = cvt_pk_bf16(v0[2], v0[3]); w.z = cvt_pk_bf16(v1[0], v1[1]); w.w = cvt_pk_bf16(v1[2], v1[3]);
                    *(u32x4*)(rowp + bj * HALF) = w; } }
    }
};
struct EpiRes {
    static constexpr bool PERM = false, AFTER_DRAIN = false;
    float* out; int ldc; bf16_t* hn; float* ssq;
    __device__ __forceinline__ void operator()(const f32x4 (&acc)[2][2][4][2], const Unit& u, int wr, int wc, int fr, int fq) const {
        typedef unsigned u32x2e __attribute__((ext_vector_type(2)));
        const int row0 = u.pm * BM + wr * 64 + fr, col0 = u.pn * BM + wc * 32 + 4 * fq;
#pragma unroll
        for (int ai = 0; ai < 2; ++ai)
#pragma unroll
            for (int m = 0; m < 4; ++m) { const int row = row0 + ai * HALF + m * 16; const size_t off = (size_t)row * ldc + col0; float s = 0.f;
#pragma unroll
                for (int bj = 0; bj < 2; ++bj)
#pragma unroll
                    for (int n = 0; n < 2; ++n) { const u32x2e hb = *(const u32x2e*)(hn + off + bj * HALF + n * 16);
                        const f32x4 b = (f32x4){__builtin_bit_cast(float, hb.x << 16), __builtin_bit_cast(float, hb.x & 0xffff0000u), __builtin_bit_cast(float, hb.y << 16), __builtin_bit_cast(float, hb.y & 0xffff0000u)};
                        const f32x4 v = b + acc[ai][bj][m][n]; if (out) *(f32x4*)(out + off + bj * HALF + n * 16) = v;
                        s += (v[0] * v[0] + v[1] * v[1]) + (v[2] * v[2] + v[3] * v[3]);
                        *(u32x2e*)(hn + off + bj * HALF + n * 16) = (u32x2e){cvt_pk_bf16(v[0], v[1]), cvt_pk_bf16(v[2], v[3])}; }
                { const int ln = fq * 16 + fr;
                  s += __builtin_bit_cast(float, __builtin_amdgcn_ds_bpermute((ln ^ 16) << 2, __builtin_bit_cast(int, s))); s += __builtin_bit_cast(float, __builtin_amdgcn_ds_bpermute((ln ^ 32) << 2, __builtin_bit_cast(int, s))); }
                if (fq == 0) ssq[(size_t)row * 16 + u.pn * 4 + wc] = s; }
    }
};

template <class Epi, class Sched, bool ALIGN_EPI = false, bool SP2 = false>
__device__ __forceinline__ void gemm_phase(PG8_LAS unsigned char* lds, const Gemm g, const Sched& S, const Epi& E) {
    int tid_o = threadIdx.x; asm volatile("" : "+v"(tid_o));
    int K_o = g.K; asm volatile("" : "+s"(K_o));
    const int tid = tid_o, wid = __builtin_amdgcn_readfirstlane(tid >> 6), lane = tid & 63, wr = wid >> 2, wc = wid & 3, fr = lane & 15, fq = lane >> 4;
    const int K = K_o, nt = K / BK;
    unsigned voffA[2], voffB[2];
#pragma unroll
    for (int i = 0; i < 2; ++i) { int R, C; stage_rc(tid * 16 + i * 8192, R, C); const int Rb = Epi::PERM ? ((R & ~31) + perm32(R & 31)) : R;
        voffA[i] = (unsigned)(R * K + C) * 2u; voffB[i] = (unsigned)(Rb * K + C) * 2u; }
    const size_t kstep = (size_t)(BK * 2);
    const size_t hstep = (size_t)HALF * K * 2;
    const size_t tstep = 2 * hstep;
    const unsigned ldsw = (unsigned)wid * 1024u;
    const int aoff = lds_byte(wr * 64 + fr, fq * 8), boff = lds_byte(wc * 32 + fr, fq * 8);
#define PG8_SA(b, h) (((b) * 2 + (h)) * HTB)
#define PG8_SB(b, h) ((4 + (b) * 2 + (h)) * HTB)
#define PG8_STAGE(bufoff, gbase, voff) do { _Pragma("unroll") for (int _i = 0; _i < 2; ++_i) \
        __builtin_amdgcn_global_load_lds((const unsigned*)((const char*)(gbase) + (voff)[_i]), (PG8_LAS unsigned*)(lds + (bufoff) + ldsw + _i * 8192), 16, 0, 0); } while (0)
#define PG8_LDA(dst, b, h) do { _Pragma("unroll") for (int m = 0; m < 4; ++m) _Pragma("unroll") for (int k = 0; k < 2; ++k) dst[m][k] = *(const PG8_LAS bf16x8*)(lds + PG8_SA(b, h) + aoff + m * 2048 + k * 1024); } while (0)
#define PG8_LDB(dst, b, h) do { _Pragma("unroll") for (int n = 0; n < 2; ++n) _Pragma("unroll") for (int k = 0; k < 2; ++k) dst[n][k] = *(const PG8_LAS bf16x8*)(lds + PG8_SB(b, h) + boff + n * 2048 + k * 1024); } while (0)
#define PG8_MMA(ai, bj, At, Bt) do { __builtin_amdgcn_s_setprio(1); _Pragma("unroll") for (int m = 0; m < 4; ++m) _Pragma("unroll") for (int n = 0; n < 2; ++n) _Pragma("unroll") for (int k = 0; k < 2; ++k) \
        acc[ai][bj][m][n] = __builtin_amdgcn_mfma_f32_16x16x32_bf16(Bt[n][k], At[m][k], acc[ai][bj][m][n], 0, 0, 0); __builtin_amdgcn_s_setprio(0); } while (0)
#define PG8_WAIT_V(n) asm volatile("s_waitcnt vmcnt(" #n ")" ::: "memory")
#define PG8_WAIT_L(n) asm volatile("s_waitcnt lgkmcnt(" #n ")" ::: "memory")
#define PG8_BAR __builtin_amdgcn_s_barrier()
#define PG8_SCHED __builtin_amdgcn_sched_barrier(0)
    Unit cur, nxt; int ui = 0;
    if (!S.next(0, cur)) return;
    f32x4 acc[2][2][4][2];
#pragma unroll
    for (int a = 0; a < 2; ++a)
#pragma unroll
        for (int b = 0; b < 2; ++b)
#pragma unroll
            for (int m = 0; m < 4; ++m)
#pragma unroll
                for (int n = 0; n < 2; ++n) acc[a][b][m][n] = (f32x4){0.f, 0.f, 0.f, 0.f};
    bf16x8 At[4][2], B0[2][2], B1[2][2];
    const char* cA = (const char*)g.A + (size_t)cur.pm * tstep; const char* cB = (const char*)g.Bt + (size_t)cur.pn * tstep;
    S.a_ready(cur);
    if constexpr (SP2) {
        PG8_STAGE(PG8_SB(0, 0), cB, voffB); PG8_STAGE(PG8_SB(0, 1), cB + hstep, voffB); PG8_STAGE(PG8_SA(0, 0), cA, voffA); PG8_STAGE(PG8_SA(0, 1), cA + hstep, voffA);
        if (wr == 1) PG8_BAR;
        PG8_WAIT_V(2); PG8_BAR;
        PG8_STAGE(PG8_SB(1, 0), cB + kstep, voffB); PG8_STAGE(PG8_SA(1, 0), cA + kstep, voffA); PG8_STAGE(PG8_SB(1, 1), cB + hstep + kstep, voffB);
        PG8_WAIT_V(6); PG8_BAR;
    } else {
        PG8_STAGE(PG8_SB(0, 0), cB, voffB); PG8_STAGE(PG8_SA(0, 0), cA, voffA); PG8_STAGE(PG8_SB(0, 1), cB + hstep, voffB); PG8_STAGE(PG8_SA(0, 1), cA + hstep, voffA);
        if (wr == 1) PG8_BAR;
        PG8_WAIT_V(4); PG8_BAR;
        PG8_STAGE(PG8_SB(1, 0), cB + kstep, voffB); PG8_STAGE(PG8_SA(1, 0), cA + kstep, voffA); PG8_STAGE(PG8_SB(1, 1), cB + hstep + kstep, voffB);
        PG8_WAIT_V(6); PG8_BAR;
    }
    for (;;) {
        const bool has_next = S.next(ui + 1, nxt);
        const char* nA = has_next ? (const char*)g.A + (size_t)nxt.pm * tstep : cA; const char* nB = has_next ? (const char*)g.Bt + (size_t)nxt.pn * tstep : cB;
        for (int t = 0; t < nt; t += 2) {
            const bool last = (t == nt - 2);
            const char* a1 = cA + (size_t)(t + 1) * kstep;
            const char* a2 = last ? nA : cA + (size_t)(t + 2) * kstep; const char* b2 = last ? nB : cB + (size_t)(t + 2) * kstep;
            const char* a3 = a2 + kstep; const char* b3 = b2 + kstep;
            if (last && has_next) S.a_ready(nxt);
            if constexpr (SP2) {
            PG8_LDB(B0, 0, 0); PG8_LDB(B1, 0, 1); PG8_SCHED; PG8_LDA(At, 0, 0); PG8_STAGE(PG8_SA(1, 1), a1 + hstep, voffA);
            PG8_WAIT_V(8); PG8_WAIT_L(0); PG8_BAR; PG8_MMA(0, 0, At, B0); PG8_MMA(0, 1, At, B1); PG8_BAR; PG8_SCHED;
            PG8_LDA(At, 0, 1); PG8_STAGE(PG8_SB(0, 0), b2, voffB); PG8_STAGE(PG8_SB(0, 1), b2 + hstep, voffB); PG8_STAGE(PG8_SA(0, 0), a2, voffA);
            PG8_WAIT_V(8); PG8_WAIT_L(0); PG8_BAR; PG8_MMA(1, 0, At, B0); PG8_MMA(1, 1, At, B1); PG8_BAR; PG8_SCHED;
            PG8_LDB(B0, 1, 0); PG8_LDB(B1, 1, 1); PG8_SCHED; PG8_LDA(At, 1, 0); PG8_STAGE(PG8_SA(0, 1), a2 + hstep, voffA);
            PG8_WAIT_V(8); PG8_WAIT_L(0); PG8_BAR; PG8_MMA(0, 0, At, B0); PG8_MMA(0, 1, At, B1); PG8_BAR; PG8_SCHED;
            PG8_LDA(At, 1, 1); PG8_STAGE(PG8_SB(1, 0), b3, voffB); PG8_STAGE(PG8_SB(1, 1), b3 + hstep, voffB); PG8_STAGE(PG8_SA(1, 0), a3, voffA);
            PG8_WAIT_V(8); PG8_WAIT_L(0); PG8_BAR; PG8_MMA(1, 0, At, B0); PG8_MMA(1, 1, At, B1); PG8_BAR; PG8_SCHED;
            } else {
            PG8_LDB(B0, 0, 0); PG8_SCHED; PG8_LDA(At, 0, 0); PG8_STAGE(PG8_SA(1, 1), a1 + hstep, voffA);
            PG8_WAIT_L(8); PG8_BAR; PG8_WAIT_L(0); PG8_MMA(0, 0, At, B0); PG8_BAR; PG8_SCHED;
            PG8_LDB(B1, 0, 1); PG8_STAGE(PG8_SB(0, 0), b2, voffB);
            PG8_BAR; PG8_WAIT_L(0); PG8_MMA(0, 1, At, B1); PG8_BAR;
            PG8_LDA(At, 0, 1); PG8_STAGE(PG8_SA(0, 0), a2, voffA);
            PG8_BAR; PG8_WAIT_L(0); PG8_MMA(1, 0, At, B0); PG8_BAR; PG8_SCHED;
            PG8_STAGE(PG8_SB(0, 1), b2 + hstep, voffB);
            PG8_WAIT_V(6); PG8_BAR; PG8_MMA(1, 1, At, B1); PG8_BAR;
            PG8_LDB(B0, 1, 0); PG8_SCHED; PG8_LDA(At, 1, 0); PG8_STAGE(PG8_SA(0, 1), a2 + hstep, voffA);
            PG8_WAIT_L(8); PG8_BAR; PG8_WAIT_L(0); PG8_MMA(0, 0, At, B0); PG8_BAR; PG8_SCHED;
            PG8_LDB(B1, 1, 1); PG8_STAGE(PG8_SB(1, 0), b3, voffB);
            PG8_BAR; PG8_WAIT_L(0); PG8_MMA(0, 1, At, B1); PG8_BAR;
            PG8_LDA(At, 1, 1); PG8_STAGE(PG8_SA(1, 0), a3, voffA);
            PG8_BAR; PG8_WAIT_L(0); PG8_MMA(1, 0, At, B0); PG8_BAR; PG8_SCHED;
            PG8_STAGE(PG8_SB(1, 1), b3 + hstep, voffB);
            PG8_WAIT_V(6); PG8_BAR; PG8_MMA(1, 1, At, B1); PG8_BAR;
            }
        }
        if constexpr (ALIGN_EPI) { if (wr == 0) PG8_BAR; }
        if constexpr (!Epi::AFTER_DRAIN) { E(acc, cur, wr, wc, fr, fq); S.done(cur); }
        if (!has_next) break;
#pragma unroll
        for (int a = 0; a < 2; ++a)
#pragma unroll
            for (int b = 0; b < 2; ++b)
#pragma unroll
                for (int m = 0; m < 4; ++m)
#pragma unroll
                    for (int n = 0; n < 2; ++n) acc[a][b][m][n] = (f32x4){0.f, 0.f, 0.f, 0.f};
        cur = nxt; cA = nA; cB = nB; ++ui;
        if constexpr (ALIGN_EPI) { if (wr == 1) PG8_BAR; }
    }
    PG8_WAIT_V(0);
    if constexpr (!ALIGN_EPI) { if (wr == 0) PG8_BAR; }
    PG8_BAR;
    if constexpr (Epi::AFTER_DRAIN) { E.fused(acc, cur, wr, wc, fr, fq, lds, wid, lane); S.done(cur); }
#undef PG8_SA
#undef PG8_SB
#undef PG8_STAGE
#undef PG8_LDA
#undef PG8_LDB
#undef PG8_MMA
#undef PG8_WAIT_V
#undef PG8_WAIT_L
#undef PG8_BAR
#undef PG8_SCHED
}
}
#define GAS __attribute__((address_space(1)))
#define LAS __attribute__((address_space(3)))
typedef unsigned short bf16;
typedef unsigned v4u __attribute__((ext_vector_type(4)));
typedef float f32x4 __attribute__((ext_vector_type(4)));
typedef float f32x2 __attribute__((ext_vector_type(2)));
typedef short bf16x8_t __attribute__((ext_vector_type(8)));
constexpr int NWAVES = 8, NT = 512;
constexpr int M = 32768, D = 1024, SEQ = 2048, NBATCH = 16, FF = 4096, DEPTH = 4;
constexpr int EVEN_IN = 3608, ODD_IN = 3336, NE = 3840, NO = 3584, PE = 3584, PO = 3328;
constexpr size_t MiB = 1u << 20;
constexpr size_t WS_W = 2 * MiB, W_LAYER = 10 * MiB, W_IN = 0, W_OUT = 8 * MiB, WS_WMLP = 42 * MiB, W_1 = 0, W_2 = 8 * MiB;
constexpr size_t WS_SSQ = 126 * MiB, WS_HF = 384 * MiB, WS_RS = 336 * MiB;
constexpr size_t WS_XN = 58 * MiB, WS_SMALL = 122 * MiB, WS_PROJ = 128 * MiB, WS_GS = 352 * MiB, WS_END = 512 * MiB;
constexpr int LDS_BYTES = 147456, MISC_OFF = 147456 - 256, RSTD_OFF = 131072;
constexpr size_t WS_CTL = 0, CTL_ZERO_BYTES = 65536; constexpr int CW_BAR = 4096;
constexpr float NORM_EPS = 1e-6f, L2_EPS = 1e-6f;

#define LDS_WAIT() asm volatile("s_waitcnt lgkmcnt(0)" ::: "memory")
#define LDS_BARRIER() do { asm volatile("s_waitcnt lgkmcnt(0)" ::: "memory"); __builtin_amdgcn_s_barrier(); asm volatile("" ::: "memory"); } while (0)
typedef __bf16 hwbf16x2_t __attribute__((ext_vector_type(2)));
__device__ __forceinline__ unsigned pk2(float lo, float hi) { const f32x2 v = {lo, hi}; return __builtin_bit_cast(unsigned, __builtin_convertvector(v, hwbf16x2_t)); }
__device__ __forceinline__ unsigned f2bf(float f) { return pk2(f, 0.f) & 0xffffu; }
__device__ __forceinline__ float bflo(unsigned u) { return __builtin_bit_cast(float, u << 16); }
__device__ __forceinline__ float bfhi(unsigned u) { return __builtin_bit_cast(float, u & 0xffff0000u); }
template <int CTRL, int RMASK, bool BC> __device__ __forceinline__ float dpp_add(float v) { return v + __builtin_bit_cast(float, __builtin_amdgcn_update_dpp(0, __builtin_bit_cast(int, v), CTRL, RMASK, 0xf, BC)); }
__device__ __forceinline__ float wave_sum(float v) {
    v = dpp_add<0x111, 0xf, true>(v); v = dpp_add<0x112, 0xf, true>(v); v = dpp_add<0x114, 0xf, true>(v); v = dpp_add<0x118, 0xf, true>(v);
    v = dpp_add<0x142, 0xa, false>(v); v = dpp_add<0x143, 0xc, false>(v);
    return __builtin_bit_cast(float, __builtin_amdgcn_readlane(__builtin_bit_cast(int, v), 63));
}
__device__ __forceinline__ float half_sum(float v, int lane) {
    v = dpp_add<0x111, 0xf, true>(v); v = dpp_add<0x112, 0xf, true>(v); v = dpp_add<0x114, 0xf, true>(v); v = dpp_add<0x118, 0xf, true>(v);
    v = dpp_add<0x142, 0xa, false>(v);
    const float lo = __builtin_bit_cast(float, __builtin_amdgcn_readlane(__builtin_bit_cast(int, v), 31)), hi = __builtin_bit_cast(float, __builtin_amdgcn_readlane(__builtin_bit_cast(int, v), 63));
    return lane < 32 ? lo : hi;
}
__device__ __forceinline__ float ftanh(float x) { return 1.f - 2.f * __builtin_amdgcn_rcpf(1.f + __expf(2.f * x)); }
template <int CTRL> __device__ __forceinline__ float dppf(float x) { return __builtin_bit_cast(float, __builtin_amdgcn_mov_dpp(__builtin_bit_cast(int, x), CTRL, 0xf, 0xf, true)); }
__device__ __forceinline__ float red4(float v) { v += dppf<0xB1>(v); v += dppf<0x4E>(v); return v; }
__device__ __forceinline__ float red8(float v) { v = red4(v); v += dppf<0x141>(v); return v; }
__device__ __forceinline__ float red16(float v) { v = red8(v); v += dppf<0x140>(v); return v; }
__device__ __forceinline__ float frcp(float x) { return __builtin_amdgcn_rcpf(x); }
__device__ __forceinline__ float frsq(float x) { return __builtin_amdgcn_rsqf(x); }
__device__ __forceinline__ float sigm(float x) { return frcp(1.f + __expf(-x)); }
__device__ __forceinline__ float silu(float x) { return x * frcp(1.f + __expf(-x)); }
__device__ __forceinline__ f32x2 silu2(f32x2 x) { const f32x2 a = x * -1.4426950408889634f; f32x2 e; e.x = __builtin_amdgcn_exp2f(a.x); e.y = __builtin_amdgcn_exp2f(a.y); e = e + 1.f; f32x2 r; r.x = __builtin_amdgcn_rcpf(e.x); r.y = __builtin_amdgcn_rcpf(e.y); return x * r; }
__device__ __forceinline__ float softplus(float x) { return fmaxf(x, 0.f) + __logf(1.f + __expf(-fabsf(x))); }

__device__ __forceinline__ void transpose_item(const float* W, int Nsrc, int K, bf16* WT, int n0, int s0, int k0, LAS float* scr, int lane, const float* ks) {
#pragma unroll 8
    for (int i = 0; i < 32; ++i) { const int kk = 2 * i + (lane >> 5); scr[kk * 33 + (lane & 31)] = W[(size_t)(k0 + kk) * Nsrc + s0 + (lane & 31)] * (ks ? ks[k0 + kk] : 1.f); }
    LDS_WAIT(); asm volatile("" ::: "memory");
    const int c = lane & 7;
#pragma unroll
    for (int j = 0; j < 4; ++j) { const int n = (lane >> 3) + 8 * j; const LAS float* s = scr + (8 * c) * 33 + n;
        v4u o; o.x = pk2(s[0 * 33], s[1 * 33]); o.y = pk2(s[2 * 33], s[3 * 33]); o.z = pk2(s[4 * 33], s[5 * 33]); o.w = pk2(s[6 * 33], s[7 * 33]);
        *(v4u*)(WT + (size_t)(n0 + n) * K + k0 + 8 * c) = o; }
    LDS_WAIT(); asm volatile("" ::: "memory");
}
__device__ __forceinline__ void transpose_matrix(const float* W, int Nsrc, int K, bf16* WT, int Nmain, int split, LAS float* scr, int gw, int NGW, int lane, const float* ks) {
    const int nblk = Nmain / 32, items = (K / 64) * nblk;
    for (int it = gw; it < items; it += NGW) { const int kb = it / nblk, nb = it % nblk, n0 = nb * 32; transpose_item(W, Nsrc, K, WT, n0, n0 < split ? n0 : n0 + 8, kb * 64, scr, lane, ks); }
}
__device__ __forceinline__ void tail_rows(const float* W, int Nsrc, bf16* WT, int Nmain, int Npad, bool even, int gt, int NGT, const float* ks) {
    const int total = (Npad - Nmain) * D;
    for (int e = gt; e < total; e += NGT) { const int r = e / D, k = e % D; int src = -1;
        if (even) { if (r < 8) src = 2048 + r; else if (r < 24) src = 3592 + (r - 8); } else { if (r < 8) src = 1536 + r; }
        WT[(size_t)(Nmain + r) * D + k] = src >= 0 ? (bf16)f2bf(W[(size_t)k * Nsrc + src] * ks[k]) : (bf16)0; }
}
__device__ __forceinline__ void norm_rows_bf16(const float* src, const float* w, bf16* dst, int gw, int NGW, int lane) {
    f32x4 wv[4];
#pragma unroll
    for (int j = 0; j < 4; ++j) wv[j] = *((const f32x4*)w + lane + 64 * j);
    for (int m = gw; m < M; m += NGW) {
        const f32x4* xr = (const f32x4*)(src + (size_t)m * D) + lane;
        f32x4 v[4]; float s = 0.f;
#pragma unroll
        for (int j = 0; j < 4; ++j) { v[j] = xr[64 * j]; s += (v[j].x * v[j].x + v[j].y * v[j].y) + (v[j].z * v[j].z + v[j].w * v[j].w); }
        const float rstd = frsq(wave_sum(s) * (1.f / D) + NORM_EPS);
        unsigned long long* o8 = (unsigned long long*)(dst + (size_t)m * D) + lane;
#pragma unroll
        for (int j = 0; j < 4; ++j) { const f32x4 y = v[j] * rstd * wv[j]; o8[64 * j] = (unsigned long long)pk2(y.x, y.y) | ((unsigned long long)pk2(y.z, y.w) << 32); }
    }
}
__device__ __forceinline__ void copy_rows_bf16_ssq(const float* src, bf16* dst, float* ssq, int gw, int NGW, int lane) {
    for (int m = gw; m < M; m += NGW) {
        const f32x4* xr = (const f32x4*)(src + (size_t)m * D) + lane;
        f32x4 v[4]; float s = 0.f;
#pragma unroll
        for (int j = 0; j < 4; ++j) { v[j] = xr[64 * j]; s += (v[j].x * v[j].x + v[j].y * v[j].y) + (v[j].z * v[j].z + v[j].w * v[j].w); }
        s = wave_sum(s);
        unsigned long long* o8 = (unsigned long long*)(dst + (size_t)m * D) + lane;
#pragma unroll
        for (int j = 0; j < 4; ++j) o8[64 * j] = (unsigned long long)pk2(v[j].x, v[j].y) | ((unsigned long long)pk2(v[j].z, v[j].w) << 32);
        if (lane < 16) ssq[(size_t)m * 16 + lane] = lane == 0 ? s : 0.f;
    }
}
__device__ __forceinline__ void norm_rows_f32(const float* src, float* dst, const float* w, int gw, int NGW, int lane) {
    f32x4 wv[4];
#pragma unroll
    for (int j = 0; j < 4; ++j) wv[j] = *((const f32x4*)w + lane + 64 * j);
    for (int m = gw; m < M; m += NGW) {
        const f32x4* xr = (const f32x4*)(src + (size_t)m * D) + lane; f32x4* yr = (f32x4*)(dst + (size_t)m * D) + lane;
        f32x4 v[4]; float s = 0.f;
#pragma unroll
        for (int j = 0; j < 4; ++j) { v[j] = xr[64 * j]; s += (v[j].x * v[j].x + v[j].y * v[j].y) + (v[j].z * v[j].z + v[j].w * v[j].w); }
        const float rstd = frsq(wave_sum(s) * (1.f / D) + NORM_EPS);
#pragma unroll
        for (int j = 0; j < 4; ++j) yr[64 * j] = v[j] * rstd * wv[j];
    }
}
#define XB_TMO      128
#define XB_XCNT(j)  (256  + 64 * (j))
#define XB_XSUB(j)  (1280 + 64 * (j))
#define XB_XGEN(j)  (2304 + 64 * (j))
#define XB_TOP      3328
#define XB_TOPGEN   3392
#define XCD_BAR_WORDS 3456
#define XB_SPIN_CAP (1u << 18)

__device__ __forceinline__ unsigned xb_ld(unsigned* p)              { return __hip_atomic_load(p, __ATOMIC_RELAXED, __HIP_MEMORY_SCOPE_AGENT); }
__device__ __forceinline__ unsigned xb_add(unsigned* p, unsigned v) { return __hip_atomic_fetch_add(p, v, __ATOMIC_RELAXED, __HIP_MEMORY_SCOPE_AGENT); }
__device__ __forceinline__ unsigned xb_xcc_id() { return (unsigned)__builtin_amdgcn_s_getreg((3 << 11) | 20) & 0xFu; }
#define XB_SPIN(cond, bar) do { unsigned _sp = 0; while (cond) { __builtin_amdgcn_s_sleep(1); \
    if ((++_sp & 255u) == 0u) { if (xb_ld(&(bar)[XB_TMO])) break; if (_sp > XB_SPIN_CAP) { atomicAdd(&(bar)[XB_TMO], 1u); break; } } } } while (0)

struct XcdBarrier {
    unsigned* bar; unsigned x;
    volatile LAS unsigned* st;
};

__device__ __forceinline__ XcdBarrier xcd_barrier_post(unsigned* bar, volatile LAS unsigned* st) {
    XcdBarrier b; b.bar = bar; b.x = xb_xcc_id(); b.st = st;
    if (threadIdx.x == 0) (void)xb_add(&bar[XB_XCNT(b.x)], 1u);
    return b;
}
__device__ __forceinline__ void xcd_barrier_complete(unsigned* bar, unsigned x, unsigned& nloc, unsigned& nx) {
    const unsigned G = gridDim.x * gridDim.y * gridDim.z;
    unsigned sum, cnt, mine, sp = 0u;
    for (;;) {
        sum = 0u; cnt = 0u; mine = 0u;
#pragma unroll
        for (unsigned j = 0; j < 16; ++j) { const unsigned c = xb_ld(&bar[XB_XCNT(j)]); sum += c; cnt += (c > 0u) ? 1u : 0u; mine = (j == x) ? c : mine; }
        if (sum == G) break;
        __builtin_amdgcn_s_sleep(1);
        if ((++sp & 255u) == 0u) { if (xb_ld(&bar[XB_TMO])) break; if (sp > XB_SPIN_CAP) { atomicAdd(&bar[XB_TMO], 1u); break; } }
    }
    nloc = mine > 0u ? mine : 1u; nx = cnt > 0u ? cnt : 1u;
}

__device__ __forceinline__ void xcd_barrier(const XcdBarrier& b) {
    asm volatile("s_waitcnt vmcnt(0)" ::: "memory");
    __syncthreads();
    if (threadIdx.x == 0) {
        unsigned* bar = b.bar; asm volatile("" : "+s"(bar));
        __builtin_amdgcn_s_waitcnt(0);
        unsigned nloc = b.st[0], nx = b.st[1];
        if (nloc == 0u) { xcd_barrier_complete(bar, b.x, nloc, nx); b.st[0] = nloc; b.st[1] = nx; }
        const unsigned old = xb_add(&bar[XB_XSUB(b.x)], 1u);
        const unsigned gen = old / nloc;
        if (old + 1u == (gen + 1u) * nloc) {
            __builtin_amdgcn_fence(__ATOMIC_RELEASE, "agent");
            asm volatile("s_waitcnt vmcnt(0)" ::: "memory");
            const unsigned og = xb_add(&bar[XB_TOP], 1u);
            const unsigned tg = og / nx;
            if (og + 1u == (tg + 1u) * nx) xb_add(&bar[XB_TOPGEN], 1u);
            else XB_SPIN(xb_ld(&bar[XB_TOPGEN]) == tg, bar);
            __builtin_amdgcn_fence(__ATOMIC_ACQUIRE, "agent");
            xb_add(&bar[XB_XGEN(b.x)], 1u);
            asm volatile("s_waitcnt vmcnt(0)" ::: "memory");
        } else {
            XB_SPIN(xb_ld(&bar[XB_XGEN(b.x)]) == gen, bar);
            __builtin_amdgcn_fence(__ATOMIC_ACQUIRE, "agent");
            asm volatile("s_waitcnt vmcnt(0)" ::: "memory");
        }
    }
    __syncthreads();
}
typedef unsigned u32x2_t __attribute__((ext_vector_type(2)));
__device__ __forceinline__ void gdn_unit(LAS unsigned char* lds, int tid, int lane, int wave, int b, int h, const bf16* PROJ, const float* SMALL, bf16* O,
                                         const float* convw, float a_log, float dt_bias, const float* normw) {
    LAS bf16* Qb = (LAS bf16*)(lds + 0); LAS bf16* Kb = (LAS bf16*)(lds + 8704); LAS bf16* QGb = (LAS bf16*)(lds + 17408);
    LAS bf16* KDT = (LAS bf16*)(lds + 26112);
    LAS bf16* RHS = (LAS bf16*)(lds + 36352); LAS float* UT = (LAS float*)(lds + 36352); LAS float* OS = (LAS float*)(lds + 36352);
    LAS bf16* VNT = (LAS bf16*)(lds + 54784);
    LAS bf16* St = (LAS bf16*)(lds + 65024);
    LAS bf16* AQK = (LAS bf16*)(lds + 99840);
    LAS float* Lf = (LAS float*)(lds + 102400);
    LAS bf16* Wb = (LAS bf16*)(lds + 107008);
    LAS float* gcs = (LAS float*)(lds + 115712); LAS float* bts = gcs + 32; LAS float* egs = bts + 32; LAS float* ekd = egs + 32; LAS float* gls = ekd + 32;
    const int fr = lane & 15, fq = lane >> 4;
    f32x4 Sacc[8];
#pragma unroll
    for (int j = 0; j < 8; ++j) Sacc[j] = (f32x4){0.f, 0.f, 0.f, 0.f};
    for (int e = tid; e < 128 * 136 / 2; e += NT) ((LAS unsigned*)St)[e] = 0u;
    const int cp = tid % 192, th = tid / 192, sec = cp >> 6, c2 = (cp & 63) * 2, col = sec * 512 + h * 128 + c2;
    float cw[4][2];
#pragma unroll
    for (int j = 0; j < 4; ++j) { cw[j][0] = convw[j * 1536 + col]; cw[j][1] = convw[j * 1536 + col + 1]; }
    const float Aexp = __expf(a_log), nw0 = normw[2 * lane], nw1 = normw[2 * lane + 1];
    const size_t rowb = (size_t)b * SEQ;
    unsigned raw[19]; float smb = 0.f, sma = 0.f;
#define GDN_PREFETCH(cn) do { const int ts_ = (cn) * 32 + th * 16; \
        if (tid < 384) { const bf16* pb_ = PROJ + (rowb + ts_) * PE + col; _Pragma("unroll") for (int j = 0; j < 19; ++j) { raw[j] = (j >= 3 || ts_ > 0) ? *(const unsigned*)(pb_ + (j - 3) * PE) : 0u; } } \
        else if (tid < 416) { const float* sm = SMALL + (rowb + (cn) * 32 + (tid - 384)) * 32; smb = sm[h]; sma = sm[4 + h]; } } while (0)
    GDN_PREFETCH(0);
    LDS_BARRIER();
    const int tid_in = tid, wave_in = wave;
    for (int c = 0; c < SEQ / 32; ++c) {
        int tid_l = tid_in, wave_l = wave_in; asm volatile("" : "+v"(tid_l), "+s"(wave_l));
        const int tid = tid_l, wave = wave_l, lane = tid & 63, fr = lane & 15, fq = lane >> 4, cp = tid % 192, th = tid / 192, sec = cp >> 6, c2 = (cp & 63) * 2, col = sec * 512 + h * 128 + c2;
        const int t0 = c * 32;
        float y0[16], y1[16];
        if (tid < 384) {
#pragma unroll
            for (int i = 0; i < 16; ++i) {
                y0[i] = silu(cw[0][0] * bflo(raw[i]) + cw[1][0] * bflo(raw[i + 1]) + cw[2][0] * bflo(raw[i + 2]) + cw[3][0] * bflo(raw[i + 3]));
                y1[i] = silu(cw[0][1] * bfhi(raw[i]) + cw[1][1] * bfhi(raw[i + 1]) + cw[2][1] * bfhi(raw[i + 2]) + cw[3][1] * bfhi(raw[i + 3])); }
            if (sec < 2) {
                const float qs_ = sec == 0 ? 0.08838834764831845f : 1.f;
#pragma unroll
                for (int i = 0; i < 16; ++i) { const float sc = qs_ * frsq(wave_sum(y0[i] * y0[i] + y1[i] * y1[i]) + L2_EPS); y0[i] *= sc; y1[i] *= sc; }
            }
        } else if (tid < 448) {
            float g = -Aexp * softplus(sma + dt_bias);
#pragma unroll
            for (int o = 1; o < 32; o <<= 1) { const float t_ = __shfl_up(g, o); if ((lane & 31) >= o) g += t_; }
            const float gl = __shfl(g, 31);
            if (lane < 32) { gcs[lane] = g; bts[lane] = sigm(smb); egs[lane] = __expf(g); ekd[lane] = __expf(gl - g); if (lane == 0) gls[0] = __expf(gl); }
        }
        if (c + 1 < SEQ / 32) GDN_PREFETCH(c + 1);
        unsigned zg[4];
#pragma unroll
        for (int i = 0; i < 4; ++i) zg[i] = *(const unsigned*)(PROJ + (rowb + t0 + wave * 4) * PE + 1536 + h * 128 + 2 * lane + i * PE);
        LDS_BARRIER();
        if (tid < 384) {
#pragma unroll
            for (int i = 0; i < 16; ++i) { const int r = th * 16 + i;
                if (sec == 0) { const float eg = egs[r]; *(LAS unsigned*)(Qb + r * 136 + c2) = pk2(y0[i], y1[i]); *(LAS unsigned*)(QGb + r * 136 + c2) = pk2(y0[i] * eg, y1[i] * eg); }
                else if (sec == 1) { const float ek = ekd[r], be = bts[r] * egs[r]; *(LAS unsigned*)(Kb + r * 136 + c2) = pk2(y0[i], y1[i]);
                    KDT[c2 * 40 + r] = (bf16)f2bf(y0[i] * ek); KDT[(c2 + 1) * 40 + r] = (bf16)f2bf(y1[i] * ek); *(LAS unsigned*)(RHS + r * 264 + 128 + c2) = pk2(y0[i] * be, y1[i] * be); }
                else { const float bt = bts[r]; *(LAS unsigned*)(RHS + r * 264 + c2) = pk2(y0[i] * bt, y1[i] * bt); } }
        }
        LDS_BARRIER();
        {
            const int which = wave >> 2, it = (wave >> 1) & 1, jt = wave & 1;
            f32x4 acc = (f32x4){0.f, 0.f, 0.f, 0.f};
            const LAS bf16* yb = (which ? Qb : Kb) + (it * 16 + fr) * 136 + 8 * fq; const LAS bf16* xb = Kb + (jt * 16 + fr) * 136 + 8 * fq;
#pragma unroll
            for (int kk = 0; kk < 4; ++kk) acc = __builtin_amdgcn_mfma_f32_16x16x32_bf16(*(const LAS bf16x8_t*)(xb + kk * 32), *(const LAS bf16x8_t*)(yb + kk * 32), acc, 0, 0, 0);
            const int i = it * 16 + fr, j0 = jt * 16 + 4 * fq; const float gi = gcs[i], bi = bts[i]; const f32x4 gj = *(const LAS f32x4*)(gcs + j0);
            float o4[4];
#pragma unroll
            for (int jj = 0; jj < 4; ++jj) { const int j = j0 + jj; const bool keep = which ? (j <= i) : (j < i); o4[jj] = keep ? acc[jj] * __expf(gi - gj[jj]) * (which ? 1.f : bi) : 0.f; }
            if (which == 0) *(LAS f32x4*)(Lf + i * 36 + j0) = (f32x4){o4[0], o4[1], o4[2], o4[3]};
            else *(LAS u32x2_t*)(AQK + i * 40 + j0) = (u32x2_t){pk2(o4[0], o4[1]), pk2(o4[2], o4[3])};
        }
        f32x2 us2[16];
        if (tid < 256) {
#pragma unroll
            for (int i = 0; i < 16; ++i) us2[i] = (f32x2){bflo((unsigned)RHS[(2 * i) * 264 + tid]), bflo((unsigned)RHS[(2 * i + 1) * 264 + tid])};
        }
        LDS_BARRIER();
        if (tid < 256) {
#pragma unroll
            for (int i = 1; i < 32; ++i) { f32x2 a0 = (f32x2){0.f, 0.f}, a1 = (f32x2){0.f, 0.f}; __builtin_amdgcn_sched_barrier(0);
#pragma unroll
                for (int j4 = 0; j4 < 8; ++j4) if (4 * j4 < i) { const f32x4 l4 = *(const LAS f32x4*)(Lf + i * 36 + 4 * j4); a0 += (f32x2){l4.x, l4.y} * us2[2 * j4]; a1 += (f32x2){l4.z, l4.w} * us2[2 * j4 + 1]; }
                const float sub = (a0.x + a0.y) + (a1.x + a1.y);
                if (i & 1) us2[i >> 1].y -= sub; else us2[i >> 1].x -= sub; }
            if (tid < 128) {
#pragma unroll
                for (int i = 0; i < 16; i += 2) *(LAS f32x4*)(UT + tid * 36 + 2 * i) = (f32x4){us2[i].x, us2[i].y, us2[i + 1].x, us2[i + 1].y};
            } else {
#pragma unroll
                for (int i = 0; i < 16; ++i) { Wb[(2 * i) * 136 + (tid - 128)] = (bf16)f2bf(us2[i].x); Wb[(2 * i + 1) * 136 + (tid - 128)] = (bf16)f2bf(us2[i].y); }
            }
        }
        LDS_BARRIER();
        const int it = wave & 1, vtb = (wave >> 1) * 2;
#pragma unroll
        for (int q = 0; q < 2; ++q) { const int vt = vtb + q; f32x4 acc = (f32x4){0.f, 0.f, 0.f, 0.f};
            const LAS bf16* xb = Wb + (it * 16 + fr) * 136 + 8 * fq; const LAS bf16* yb = St + (vt * 16 + fr) * 136 + 8 * fq;
#pragma unroll
            for (int kk = 0; kk < 4; ++kk) acc = __builtin_amdgcn_mfma_f32_16x16x32_bf16(*(const LAS bf16x8_t*)(xb + kk * 32), *(const LAS bf16x8_t*)(yb + kk * 32), acc, 0, 0, 0);
            const f32x4 u4 = *(const LAS f32x4*)(UT + (vt * 16 + fr) * 36 + it * 16 + 4 * fq); const f32x4 vn = u4 - acc;
            *(LAS u32x2_t*)(VNT + (vt * 16 + fr) * 40 + it * 16 + 4 * fq) = (u32x2_t){pk2(vn.x, vn.y), pk2(vn.z, vn.w)}; }
        LDS_BARRIER();
#pragma unroll
        for (int q = 0; q < 2; ++q) { const int vt = vtb + q; f32x4 acc = (f32x4){0.f, 0.f, 0.f, 0.f};
            const LAS bf16* xb = QGb + (it * 16 + fr) * 136 + 8 * fq; const LAS bf16* yb = St + (vt * 16 + fr) * 136 + 8 * fq;
#pragma unroll
            for (int kk = 0; kk < 4; ++kk) acc = __builtin_amdgcn_mfma_f32_16x16x32_bf16(*(const LAS bf16x8_t*)(xb + kk * 32), *(const LAS bf16x8_t*)(yb + kk * 32), acc, 0, 0, 0);
            acc = __builtin_amdgcn_mfma_f32_16x16x32_bf16(*(const LAS bf16x8_t*)(AQK + (it * 16 + fr) * 40 + 8 * fq), *(const LAS bf16x8_t*)(VNT + (vt * 16 + fr) * 40 + 8 * fq), acc, 0, 0, 0);
#pragma unroll
            for (int jj = 0; jj < 4; ++jj) OS[(it * 16 + 4 * fq + jj) * 132 + vt * 16 + fr] = acc[jj]; }
        {
            const float gl = gls[0]; const bf16x8_t xk = *(const LAS bf16x8_t*)(KDT + (wave * 16 + fr) * 40 + 8 * fq);
#pragma unroll
            for (int vt = 0; vt < 8; ++vt) Sacc[vt] = __builtin_amdgcn_mfma_f32_16x16x32_bf16(xk, *(const LAS bf16x8_t*)(VNT + (vt * 16 + fr) * 40 + 8 * fq), Sacc[vt] * gl, 0, 0, 0);
        }
        LDS_BARRIER();
#pragma unroll
        for (int vt = 0; vt < 8; ++vt) *(LAS u32x2_t*)(St + (vt * 16 + fr) * 136 + wave * 16 + 4 * fq) = (u32x2_t){pk2(Sacc[vt].x, Sacc[vt].y), pk2(Sacc[vt].z, Sacc[vt].w)};
#pragma unroll
        for (int i = 0; i < 4; ++i) { const int t = wave * 4 + i; const f32x2 x = *((const LAS f32x2*)(OS + t * 132) + lane);
            const float r = frsq(wave_sum(x.x * x.x + x.y * x.y) * (1.f / 128.f) + NORM_EPS);
            *(unsigned*)(O + (rowb + t0 + t) * D + h * 128 + 2 * lane) = pk2(x.x * r * nw0 * silu(bflo(zg[i])), x.y * r * nw1 * silu(bfhi(zg[i]))); }
    }
    LDS_BARRIER();
#undef GDN_PREFETCH
}
__device__ __forceinline__ void gla_unit(LAS unsigned char* lds, int tid, int lane, int wave, int b, int h, const bf16* PROJ, const float* SMALL, bf16* O,
                                         const float* gw2, const float* gb, const float* normw) {
    LAS float* qs = (LAS float*)lds; LAS float* ks = qs + 4096; LAS float* as = ks + 4096; LAS float* vs = as + 4096; LAS float* os = vs + 8192; LAS float* gl = os + 8192;
    const int v = tid >> 2, kq = tid & 3;
    f32x2 S[8];
#pragma unroll
    for (int j = 0; j < 8; ++j) S[j] = (f32x2){0.f, 0.f};
    const int ach = tid & 63, atg = tid >> 6;
    float w2c[16];
#pragma unroll
    for (int r = 0; r < 16; ++r) w2c[r] = gw2[r * 256 + h * 64 + ach];
    const float gbc = gb[h * 64 + ach], nw0 = normw[2 * lane], nw1 = normw[2 * lane + 1];
    const size_t rowb = (size_t)b * SEQ;
    unsigned rq[4], rk[4], rv[8]; float rg[2];
#define GLA_PREFETCH(cn) do { const size_t r0_ = rowb + (cn) * 64; \
        const bf16* pq_ = PROJ + (r0_ + (tid >> 5)) * PE + h * 64 + 2 * (tid & 31); const bf16* pv_ = PROJ + (r0_ + (tid >> 6)) * PE + 2560 + h * 128 + 2 * (tid & 63); const float* pg_ = SMALL + (r0_ + (tid >> 4)) * 32 + 8 + (tid & 15); \
        _Pragma("unroll") for (int i = 0; i < 4; ++i) { rq[i] = *(const unsigned*)(pq_ + 2048 + i * 16 * PE); rk[i] = *(const unsigned*)(pq_ + 2304 + i * 16 * PE); } \
        _Pragma("unroll") for (int i = 0; i < 8; ++i) { rv[i] = *(const unsigned*)(pv_ + i * 8 * PE); } \
        _Pragma("unroll") for (int i = 0; i < 2; ++i) { rg[i] = pg_[i * 32 * 32]; } } while (0)
    GLA_PREFETCH(0);
    for (int c = 0; c < SEQ / 64; ++c) {
        const int t0 = c * 64;
#pragma unroll
        for (int i = 0; i < 4; ++i) { const int e = tid + i * NT, t = e >> 5, p = e & 31;
            *(LAS f32x2*)(qs + t * 64 + 2 * p) = (f32x2){bflo(rq[i]) * 0.125f, bfhi(rq[i]) * 0.125f}; *(LAS f32x2*)(ks + t * 64 + 2 * p) = (f32x2){bflo(rk[i]), bfhi(rk[i])}; }
#pragma unroll
        for (int i = 0; i < 8; ++i) { const int e = tid + i * NT, t = e >> 6, p = e & 63; *(LAS f32x2*)(vs + t * 128 + 2 * p) = (f32x2){bflo(rv[i]), bfhi(rv[i])}; }
#pragma unroll
        for (int i = 0; i < 2; ++i) gl[tid + i * NT] = rg[i];
        if (c + 1 < SEQ / 64) GLA_PREFETCH(c + 1);
        unsigned zg[8];
#pragma unroll
        for (int i = 0; i < 8; ++i) zg[i] = *(const unsigned*)(PROJ + (rowb + t0 + wave * 8) * PE + 3072 + h * 128 + 2 * lane + i * PE);
        LDS_BARRIER();
#pragma unroll
        for (int i = 0; i < 8; ++i) { const int t = atg * 8 + i; float la = gbc;
#pragma unroll
            for (int r = 0; r < 16; r += 4) { const f32x4 g4 = *(const LAS f32x4*)(gl + t * 16 + r); la += (g4.x * w2c[r] + g4.y * w2c[r + 1]) + (g4.z * w2c[r + 2] + g4.w * w2c[r + 3]); }
            as[t * 64 + ach] = __expf(fmaxf(-softplus(-la) * (1.f / 16.f), -1.f)); }
        LDS_BARRIER();
        {
            f32x4 kc[4], qc[4], ac[4]; float vc = vs[v];
#pragma unroll
            for (int i = 0; i < 4; ++i) { kc[i] = *(const LAS f32x4*)(ks + 4 * kq + 16 * i); qc[i] = *(const LAS f32x4*)(qs + 4 * kq + 16 * i); ac[i] = *(const LAS f32x4*)(as + 4 * kq + 16 * i); }
#pragma unroll 2
            for (int t = 0; t < 64; ++t) {
                const int tn = t < 63 ? t + 1 : 63;
                f32x4 kn[4], qn[4], an[4]; const float vnx = vs[tn * 128 + v];
#pragma unroll
                for (int i = 0; i < 4; ++i) { kn[i] = *(const LAS f32x4*)(ks + tn * 64 + 4 * kq + 16 * i); qn[i] = *(const LAS f32x4*)(qs + tn * 64 + 4 * kq + 16 * i); an[i] = *(const LAS f32x4*)(as + tn * 64 + 4 * kq + 16 * i); }
                f32x2 po = (f32x2){0.f, 0.f};
#pragma unroll
                for (int i = 0; i < 4; ++i) {
                    S[2 * i] = S[2 * i] * (f32x2){ac[i].x, ac[i].y} + (f32x2){kc[i].x, kc[i].y} * vc; S[2 * i + 1] = S[2 * i + 1] * (f32x2){ac[i].z, ac[i].w} + (f32x2){kc[i].z, kc[i].w} * vc;
                    po += S[2 * i] * (f32x2){qc[i].x, qc[i].y}; po += S[2 * i + 1] * (f32x2){qc[i].z, qc[i].w}; }
                const float o = red4(po.x + po.y);
                if (kq == 0) os[t * 128 + v] = o;
#pragma unroll
                for (int i = 0; i < 4; ++i) { kc[i] = kn[i]; qc[i] = qn[i]; ac[i] = an[i]; }
                vc = vnx;
            }
        }
        LDS_BARRIER();
#pragma unroll
        for (int i = 0; i < 8; ++i) { const int t = wave * 8 + i; const f32x2 x = *((const LAS f32x2*)(os + t * 128) + lane);
            const float r = frsq(wave_sum(x.x * x.x + x.y * x.y) * (1.f / 128.f) + NORM_EPS);
            *(unsigned*)(O + (rowb + t0 + t) * D + 512 + h * 128 + 2 * lane) = pk2(x.x * r * nw0 * silu(bflo(zg[i])), x.y * r * nw1 * silu(bfhi(zg[i]))); }
        LDS_BARRIER();
    }
#undef GLA_PREFETCH
}
constexpr int GI_QG = 0, GI_KDT = 8704, GI_AQK = 18944, GI_W = 21504, GI_UT = 30208, GI_GL = 40448, GI_BYTES = 40512;
__device__ __forceinline__ void gdn_phase_a(LAS unsigned char* lds, int tid_in, int wave_in, int first, int stride, const bf16* PROJ, const float* SMALL, unsigned char* GS, const float* convw_l, const float* gdn_alog, const float* gdn_dtb) {
    LAS bf16* QGb = (LAS bf16*)(lds + GI_QG); LAS bf16* KDT = (LAS bf16*)(lds + GI_KDT); LAS bf16* AQK = (LAS bf16*)(lds + GI_AQK); LAS bf16* Wb = (LAS bf16*)(lds + GI_W); LAS bf16* UTb = (LAS bf16*)(lds + GI_UT);
    LAS bf16* Qb = (LAS bf16*)(lds + 40512); LAS bf16* Kb = (LAS bf16*)(lds + 49216); LAS bf16* RHS = (LAS bf16*)(lds + 57920); LAS float* Lf = (LAS float*)(lds + 74816);
    LAS float* gcs = (LAS float*)(lds + 79424); LAS float* bts = gcs + 32; LAS float* egs = bts + 32; LAS float* ekd = egs + 32; LAS float* gls = ekd + 32;
    unsigned raw[19]; float smb = 0.f, sma = 0.f, cwn[4][2];
#define GDNA_PREFETCH(item) do { const int c_ = (item) & 63, h_ = ((item) >> 6) & 3, b_ = ((item) & 4095) >> 8; const int cp_ = tid_in % 192, th_ = tid_in / 192, col_ = (cp_ >> 6) * 512 + h_ * 128 + (cp_ & 63) * 2; const int ts_ = c_ * 32 + th_ * 16; \
        if (tid_in < 384) { const bf16* pb_ = PROJ + ((size_t)b_ * SEQ + ts_) * PE + col_; _Pragma("unroll") for (int j = 0; j < 19; ++j) { raw[j] = (j >= 3 || ts_ > 0) ? *(const unsigned*)(pb_ + (j - 3) * PE) : 0u; } \
            _Pragma("unroll") for (int j = 0; j < 4; ++j) { cwn[j][0] = convw_l[j * 1536 + col_]; cwn[j][1] = convw_l[j * 1536 + col_ + 1]; } } \
        else if (tid_in < 416) { const float* sm = SMALL + ((size_t)b_ * SEQ + c_ * 32 + (tid_in - 384)) * 32; smb = sm[h_]; sma = sm[4 + h_]; } } while (0)
#ifndef GDNA_NITEMS
#define GDNA_NITEMS 4096
#endif
    if (first < GDNA_NITEMS) GDNA_PREFETCH(first);
    for (int item = first; item < GDNA_NITEMS; item += stride) {
        int tid_l = tid_in, wave_l = wave_in; asm volatile("" : "+v"(tid_l), "+s"(wave_l));
        const int tid = tid_l, wave = wave_l, lane = tid & 63, fr = lane & 15, fq = lane >> 4, cp = tid % 192, th = tid / 192, sec = cp >> 6, c2 = (cp & 63) * 2;
        float y0[16], y1[16];
        if (tid < 384) {
            f32x2 xv[19];
#pragma unroll
            for (int j = 0; j < 19; ++j) xv[j] = (f32x2){bflo(raw[j]), bfhi(raw[j])};
            const f32x2 c0v = {cwn[0][0], cwn[0][1]}, c1v = {cwn[1][0], cwn[1][1]}, c2v = {cwn[2][0], cwn[2][1]}, c3v = {cwn[3][0], cwn[3][1]};
#pragma unroll
            for (int i = 0; i < 16; ++i) { const f32x2 yv = silu2((c0v * xv[i] + c1v * xv[i + 1]) + (c2v * xv[i + 2] + c3v * xv[i + 3])); y0[i] = yv.x; y1[i] = yv.y; }
            if (sec < 2) {
                const float qs_ = sec == 0 ? 0.08838834764831845f : 1.f;
#pragma unroll
                for (int i = 0; i < 16; ++i) { const float sc = qs_ * frsq(wave_sum(y0[i] * y0[i] + y1[i] * y1[i]) + L2_EPS); y0[i] *= sc; y1[i] *= sc; }
            }
        } else if (tid < 448) {
            const int h_ = (item >> 6) & 3;
            float g = -__expf(gdn_alog[h_]) * softplus(sma + gdn_dtb[h_]);
#pragma unroll
            for (int o = 1; o < 32; o <<= 1) { const float t_ = __shfl_up(g, o); if ((lane & 31) >= o) g += t_; }
            const float gl = __shfl(g, 31);
            if (lane < 32) { gcs[lane] = g; bts[lane] = sigm(smb); egs[lane] = __expf(g); ekd[lane] = __expf(gl - g); if (lane == 0) gls[0] = __expf(gl); }
        }
        if (item + stride < GDNA_NITEMS) GDNA_PREFETCH(item + stride);
        LDS_BARRIER();
        if (tid < 384) {
            if (sec == 0) {
#pragma unroll
                for (int i = 0; i < 16; ++i) { const int r = th * 16 + i; const float eg = egs[r]; *(LAS unsigned*)(Qb + r * 136 + c2) = pk2(y0[i], y1[i]); *(LAS unsigned*)(QGb + r * 136 + c2) = pk2(y0[i] * eg, y1[i] * eg); }
            } else if (sec == 1) {
                float e0[16], e1[16];
#pragma unroll
                for (int i = 0; i < 16; ++i) { const int r = th * 16 + i; const float ek = ekd[r], be = bts[r] * egs[r]; *(LAS unsigned*)(Kb + r * 136 + c2) = pk2(y0[i], y1[i]);
                    e0[i] = y0[i] * ek; e1[i] = y1[i] * ek; *(LAS unsigned*)(RHS + r * 264 + 128 + c2) = pk2(y0[i] * be, y1[i] * be); }
#pragma unroll
                for (int h8 = 0; h8 < 2; ++h8) { *(LAS v4u*)(KDT + c2 * 40 + th * 16 + 8 * h8) = (v4u){pk2(e0[8 * h8], e0[8 * h8 + 1]), pk2(e0[8 * h8 + 2], e0[8 * h8 + 3]), pk2(e0[8 * h8 + 4], e0[8 * h8 + 5]), pk2(e0[8 * h8 + 6], e0[8 * h8 + 7])};
                    *(LAS v4u*)(KDT + (c2 + 1) * 40 + th * 16 + 8 * h8) = (v4u){pk2(e1[8 * h8], e1[8 * h8 + 1]), pk2(e1[8 * h8 + 2], e1[8 * h8 + 3]), pk2(e1[8 * h8 + 4], e1[8 * h8 + 5]), pk2(e1[8 * h8 + 6], e1[8 * h8 + 7])}; }
            } else {
#pragma unroll
                for (int i = 0; i < 16; ++i) { const int r = th * 16 + i; const float bt = bts[r]; *(LAS unsigned*)(RHS + r * 264 + c2) = pk2(y0[i] * bt, y1[i] * bt); }
            }
        } else if (tid == 448) *(LAS float*)(lds + GI_GL) = gls[0];
        LDS_BARRIER();
        {
            const int which = wave >> 2, it = (wave >> 1) & 1, jt = wave & 1;
            f32x4 acc = (f32x4){0.f, 0.f, 0.f, 0.f};
            const LAS bf16* yb = (which ? Qb : Kb) + (it * 16 + fr) * 136 + 8 * fq; const LAS bf16* xb = Kb + (jt * 16 + fr) * 136 + 8 * fq;
#pragma unroll
            for (int kk = 0; kk < 4; ++kk) acc = __builtin_amdgcn_mfma_f32_16x16x32_bf16(*(const LAS bf16x8_t*)(xb + kk * 32), *(const LAS bf16x8_t*)(yb + kk * 32), acc, 0, 0, 0);
            const int i = it * 16 + fr, j0 = jt * 16 + 4 * fq; const float gi = gcs[i], bi = bts[i]; const f32x4 gj = *(const LAS f32x4*)(gcs + j0);
            float o4[4];
#pragma unroll
            for (int jj = 0; jj < 4; ++jj) { const int j = j0 + jj; const bool keep = which ? (j <= i) : (j < i); o4[jj] = keep ? acc[jj] * __expf(gi - gj[jj]) * (which ? 1.f : bi) : 0.f; }
            if (which == 0) *(LAS f32x4*)(Lf + i * 36 + j0) = (f32x4){o4[0], o4[1], o4[2], o4[3]};
            else *(LAS u32x2_t*)(AQK + i * 40 + j0) = (u32x2_t){pk2(o4[0], o4[1]), pk2(o4[2], o4[3])};
        }
        f32x2 us2[16];
        if (tid < 256) {
#pragma unroll
            for (int i = 0; i < 16; ++i) us2[i] = (f32x2){bflo((unsigned)RHS[(2 * i) * 264 + tid]), bflo((unsigned)RHS[(2 * i + 1) * 264 + tid])};
        }
        LDS_BARRIER();
        if (tid < 256) {
            const LAS float* Lfv = Lf; asm volatile("" : "+v"(Lfv));
            f32x4 lc[8], ln[8];
#pragma unroll
            for (int j4 = 0; j4 < 8; ++j4) { lc[j4] = (f32x4){0.f, 0.f, 0.f, 0.f}; ln[j4] = lc[j4]; }
            lc[0] = *(const LAS f32x4*)(Lfv + 36);
#pragma unroll
            for (int i = 1; i < 32; ++i) { f32x2 a0 = (f32x2){0.f, 0.f}, a1 = (f32x2){0.f, 0.f}; __builtin_amdgcn_sched_barrier(0);
                if (i + 1 < 32) {
#pragma unroll
                    for (int j4 = 0; j4 < 8; ++j4) if (4 * j4 < i + 1) ln[j4] = *(const LAS f32x4*)(Lfv + (i + 1) * 36 + 4 * j4); }
#pragma unroll
                for (int j4 = 0; j4 < 8; ++j4) if (4 * j4 < i) { const f32x4 l4 = lc[j4]; a0 += (f32x2){l4.x, l4.y} * us2[2 * j4]; a1 += (f32x2){l4.z, l4.w} * us2[2 * j4 + 1]; }
                const float sub = (a0.x + a0.y) + (a1.x + a1.y);
                if (i & 1) us2[i >> 1].y -= sub; else us2[i >> 1].x -= sub;
#pragma unroll
                for (int j4 = 0; j4 < 8; ++j4) lc[j4] = ln[j4]; }
            if (tid < 128) {
#pragma unroll
                for (int i = 0; i < 16; i += 4) *(LAS v4u*)(UTb + tid * 40 + 2 * i) = (v4u){pk2(us2[i].x, us2[i].y), pk2(us2[i + 1].x, us2[i + 1].y), pk2(us2[i + 2].x, us2[i + 2].y), pk2(us2[i + 3].x, us2[i + 3].y)};
            } else {
#pragma unroll
                for (int i = 0; i < 16; ++i) { Wb[(2 * i) * 136 + (tid - 128)] = (bf16)f2bf(us2[i].x); Wb[(2 * i + 1) * 136 + (tid - 128)] = (bf16)f2bf(us2[i].y); }
            }
        }
        LDS_BARRIER();
        { v4u* dst = (v4u*)(GS + (size_t)(item & 4095) * GI_BYTES);
#pragma unroll
          for (int k = 0; k < 5; ++k) { const int e = tid + k * NT; if (e < GI_BYTES / 16) dst[e] = *(const LAS v4u*)(lds + e * 16); } }
    }
    LDS_BARRIER();
#undef GDNA_PREFETCH
}
__device__ __forceinline__ void gdn_phase_b(LAS unsigned char* lds, int tid_in, int wave_in, int b, int h, const bf16* PROJ, const unsigned char* GS, bf16* O, const float* normw) {
    LAS bf16* QGb = (LAS bf16*)(lds + GI_QG); LAS bf16* KDT = (LAS bf16*)(lds + GI_KDT); LAS bf16* AQK = (LAS bf16*)(lds + GI_AQK); LAS bf16* Wb = (LAS bf16*)(lds + GI_W); LAS bf16* UTb = (LAS bf16*)(lds + GI_UT);
    LAS bf16* VNT = (LAS bf16*)(lds + 40512); LAS bf16* St = (LAS bf16*)(lds + 50752); LAS float* OS = (LAS float*)(lds + 85568);
    f32x4 Sacc[8];
#pragma unroll
    for (int j = 0; j < 8; ++j) Sacc[j] = (f32x4){0.f, 0.f, 0.f, 0.f};
    for (int e = tid_in; e < 128 * 136 / 2; e += NT) ((LAS unsigned*)St)[e] = 0u;
    const float nw0 = normw[2 * (tid_in & 63)], nw1 = normw[2 * (tid_in & 63) + 1];
    const size_t rowb = (size_t)b * SEQ;
    const unsigned char* gsb = GS + (size_t)((b * 4 + h) * 64) * GI_BYTES;
    v4u ring[4][5]; unsigned zring[4][4];
#define GDNB_PREFETCH(cn, st) do { const v4u* src_ = (const v4u*)(gsb + (size_t)(cn) * GI_BYTES); _Pragma("unroll") for (int k = 0; k < 5; ++k) { const int e = tid_in + k * NT; if (e < GI_BYTES / 16) ring[st][k] = src_[e]; } \
        _Pragma("unroll") for (int i = 0; i < 4; ++i) zring[st][i] = *(const unsigned*)(PROJ + (rowb + (cn) * 32 + wave_in * 4) * PE + 1536 + h * 128 + 2 * (tid_in & 63) + i * PE); } while (0)
    GDNB_PREFETCH(0, 0); GDNB_PREFETCH(1, 1); GDNB_PREFETCH(2, 2); GDNB_PREFETCH(3, 3);
    for (int c0 = 0; c0 < SEQ / 32; c0 += 4) {
#pragma unroll
      for (int st = 0; st < 4; ++st) { const int c = c0 + st;
        int tid_l = tid_in, wave_l = wave_in; asm volatile("" : "+v"(tid_l), "+s"(wave_l));
        const int tid = tid_l, wave = wave_l, lane = tid & 63, fr = lane & 15, fq = lane >> 4;
        const int t0 = c * 32;
#pragma unroll
        for (int k = 0; k < 5; ++k) { const int e = tid + k * NT; if (e < GI_BYTES / 16) *(LAS v4u*)(lds + e * 16) = ring[st][k]; }
        unsigned zg[4];
#pragma unroll
        for (int i = 0; i < 4; ++i) zg[i] = zring[st][i];
        if (c + 4 < SEQ / 32) GDNB_PREFETCH(c + 4, st);
        LDS_BARRIER();
        const int it = wave & 1, vtb = (wave >> 1) * 2;
#pragma unroll
        for (int q = 0; q < 2; ++q) { const int vt = vtb + q; f32x4 acc = (f32x4){0.f, 0.f, 0.f, 0.f};
            const LAS bf16* xb = Wb + (it * 16 + fr) * 136 + 8 * fq; const LAS bf16* yb = St + (vt * 16 + fr) * 136 + 8 * fq;
#pragma unroll
            for (int kk = 0; kk < 4; ++kk) acc = __builtin_amdgcn_mfma_f32_16x16x32_bf16(*(const LAS bf16x8_t*)(xb + kk * 32), *(const LAS bf16x8_t*)(yb + kk * 32), acc, 0, 0, 0);
            const u32x2_t ub = *(const LAS u32x2_t*)(UTb + (vt * 16 + fr) * 40 + it * 16 + 4 * fq);
            const f32x4 vn = (f32x4){bflo(ub.x), bfhi(ub.x), bflo(ub.y), bfhi(ub.y)} - acc;
            *(LAS u32x2_t*)(VNT + (vt * 16 + fr) * 40 + it * 16 + 4 * fq) = (u32x2_t){pk2(vn.x, vn.y), pk2(vn.z, vn.w)}; }
        LDS_BARRIER();
#pragma unroll
        for (int q = 0; q < 2; ++q) { const int vt = vtb + q; f32x4 acc = (f32x4){0.f, 0.f, 0.f, 0.f};
            const LAS bf16* xb = QGb + (it * 16 + fr) * 136 + 8 * fq; const LAS bf16* yb = St + (vt * 16 + fr) * 136 + 8 * fq;
#pragma unroll
            for (int kk = 0; kk < 4; ++kk) acc = __builtin_amdgcn_mfma_f32_16x16x32_bf16(*(const LAS bf16x8_t*)(xb + kk * 32), *(const LAS bf16x8_t*)(yb + kk * 32), acc, 0, 0, 0);
            acc = __builtin_amdgcn_mfma_f32_16x16x32_bf16(*(const LAS bf16x8_t*)(AQK + (it * 16 + fr) * 40 + 8 * fq), *(const LAS bf16x8_t*)(VNT + (vt * 16 + fr) * 40 + 8 * fq), acc, 0, 0, 0);
#pragma unroll
            for (int jj = 0; jj < 4; ++jj) OS[(it * 16 + 4 * fq + jj) * 132 + vt * 16 + fr] = acc[jj]; }
        {
            const float gl = *(const LAS float*)(lds + GI_GL); const bf16x8_t xk = *(const LAS bf16x8_t*)(KDT + (wave * 16 + fr) * 40 + 8 * fq);
#pragma unroll
            for (int vt = 0; vt < 8; ++vt) Sacc[vt] = __builtin_amdgcn_mfma_f32_16x16x32_bf16(xk, *(const LAS bf16x8_t*)(VNT + (vt * 16 + fr) * 40 + 8 * fq), Sacc[vt] * gl, 0, 0, 0);
        }
        LDS_BARRIER();
#pragma unroll
        for (int vt = 0; vt < 8; ++vt) *(LAS u32x2_t*)(St + (vt * 16 + fr) * 136 + wave * 16 + 4 * fq) = (u32x2_t){pk2(Sacc[vt].x, Sacc[vt].y), pk2(Sacc[vt].z, Sacc[vt].w)};
#pragma unroll
        for (int i = 0; i < 4; ++i) { const int t = wave * 4 + i; const f32x2 x = *((const LAS f32x2*)(OS + t * 132) + lane);
            const float r = frsq(wave_sum(x.x * x.x + x.y * x.y) * (1.f / 128.f) + NORM_EPS);
            *(unsigned*)(O + (rowb + t0 + t) * D + h * 128 + 2 * lane) = pk2(x.x * r * nw0 * silu(bflo(zg[i])), x.y * r * nw1 * silu(bfhi(zg[i]))); }
      }
    }
    LDS_BARRIER();
#undef GDNB_PREFETCH
}
__device__ __forceinline__ void gla_chunked(LAS unsigned char* lds, int tid_in, int wave_in, int b, int h, const bf16* PROJ, const float* SMALL, bf16* O, const float* gw2, const float* gb, const float* normw) {
    LAS bf16* QG = (LAS bf16*)(lds + 0); LAS bf16* KG = (LAS bf16*)(lds + 4608); LAS bf16* KDT = (LAS bf16*)(lds + 9216); LAS bf16* VT = (LAS bf16*)(lds + 14336); LAS bf16* ATT = (LAS bf16*)(lds + 24576);
    LAS bf16* ST = (LAS bf16*)(lds + 27136); LAS float* OS = (LAS float*)(lds + 45568); LAS float* LA = (LAS float*)(lds + 62464); LAS float* GLR = (LAS float*)(lds + 70656); LAS float* GLS = (LAS float*)(lds + 72704);
    f32x4 Sacc[4];
#pragma unroll
    for (int j = 0; j < 4; ++j) Sacc[j] = (f32x4){0.f, 0.f, 0.f, 0.f};
    for (int e = tid_in; e < 128 * 72 / 2; e += NT) ((LAS unsigned*)ST)[e] = 0u;
    float w2c[16];
#pragma unroll
    for (int r = 0; r < 16; ++r) w2c[r] = gw2[r * 256 + h * 64 + (tid_in & 63)];
    const float gbc = gb[h * 64 + (tid_in & 63)], nw0 = normw[2 * (tid_in & 63)], nw1 = normw[2 * (tid_in & 63) + 1];
    const size_t rowb = (size_t)b * SEQ;
    unsigned rq[2], rk[2], rv[4]; float rg;
#define GLA2_PREFETCH(cn) do { const size_t r0_ = rowb + (cn) * 32; \
        const bf16* pq_ = PROJ + (r0_ + (tid_in >> 5)) * PE + h * 64 + 2 * (tid_in & 31); const bf16* pv_ = PROJ + (r0_ + (tid_in >> 6)) * PE + 2560 + h * 128 + 2 * (tid_in & 63); \
        _Pragma("unroll") for (int i = 0; i < 2; ++i) { rq[i] = *(const unsigned*)(pq_ + 2048 + i * 16 * PE); rk[i] = *(const unsigned*)(pq_ + 2304 + i * 16 * PE); } \
        _Pragma("unroll") for (int i = 0; i < 4; ++i) { rv[i] = *(const unsigned*)(pv_ + i * 8 * PE); } \
        rg = SMALL[(r0_ + (tid_in >> 4)) * 32 + 8 + (tid_in & 15)]; } while (0)
    GLA2_PREFETCH(0);
    LDS_BARRIER();
    for (int c = 0; c < SEQ / 32; ++c) {
        int tid_l = tid_in, wave_l = wave_in; asm volatile("" : "+v"(tid_l), "+s"(wave_l));
        const int tid = tid_l, wave = wave_l, lane = tid & 63, fr = lane & 15, fq = lane >> 4;
        const int t0 = c * 32;
        GLR[tid] = rg;
        const unsigned cq0 = rq[0], cq1 = rq[1], ck0 = rk[0], ck1 = rk[1], cv0 = rv[0], cv1 = rv[1], cv2 = rv[2], cv3 = rv[3];
        if (c + 1 < SEQ / 32) GLA2_PREFETCH(c + 1);
        unsigned zg[4];
#pragma unroll
        for (int i = 0; i < 4; ++i) zg[i] = *(const unsigned*)(PROJ + (rowb + t0 + wave * 4) * PE + 3072 + h * 128 + 2 * lane + i * PE);
        LDS_BARRIER();
#pragma unroll
        for (int i = 0; i < 4; ++i) { const int t = wave * 4 + i; float la = gbc;
#pragma unroll
            for (int r = 0; r < 16; r += 4) { const f32x4 g4 = *(const LAS f32x4*)(GLR + t * 16 + r); la += (g4.x * w2c[r] + g4.y * w2c[r + 1]) + (g4.z * w2c[r + 2] + g4.w * w2c[r + 3]); }
            LA[t * 64 + lane] = fmaxf(-softplus(-la) * (1.f / 16.f), -1.f); }
        LDS_BARRIER();
        if (tid < 64) { float acc = 0.f, col[32];
#pragma unroll
            for (int t = 0; t < 32; ++t) col[t] = LA[t * 64 + tid];
#pragma unroll
            for (int t = 0; t < 32; ++t) { acc += col[t]; LA[t * 64 + tid] = acc; }
            GLS[tid] = __expf(acc); }
        LDS_BARRIER();
        {
            const unsigned cqs[2] = {cq0, cq1}, cks[2] = {ck0, ck1}, cvs[4] = {cv0, cv1, cv2, cv3};
#pragma unroll
            for (int i = 0; i < 2; ++i) { const int t = (tid >> 5) + 16 * i, p = tid & 31; const f32x2 gc = *(const LAS f32x2*)(LA + t * 64 + 2 * p); const f32x2 gls = *(const LAS f32x2*)(GLS + 2 * p);
                const float e0 = __expf(gc.x), e1 = __expf(gc.y), n0 = __expf(-gc.x), n1 = __expf(-gc.y), k0 = bflo(cks[i]), k1 = bfhi(cks[i]);
                *(LAS unsigned*)(QG + t * 72 + 2 * p) = pk2(bflo(cqs[i]) * 0.125f * e0, bfhi(cqs[i]) * 0.125f * e1);
                *(LAS unsigned*)(KG + t * 72 + 2 * p) = pk2(k0 * n0, k1 * n1);
                KDT[(2 * p) * 40 + t] = (bf16)f2bf(k0 * n0 * gls.x); KDT[(2 * p + 1) * 40 + t] = (bf16)f2bf(k1 * n1 * gls.y); }
#pragma unroll
            for (int i = 0; i < 4; ++i) { const int t = (tid >> 6) + 8 * i, p = tid & 63; VT[(2 * p) * 40 + t] = (bf16)(cvs[i] & 0xffffu); VT[(2 * p + 1) * 40 + t] = (bf16)(cvs[i] >> 16); }
        }
        LDS_BARRIER();
        if (wave < 4) { const int it = wave >> 1, jt = wave & 1; f32x4 acc = (f32x4){0.f, 0.f, 0.f, 0.f};
#pragma unroll
            for (int kk = 0; kk < 2; ++kk) acc = __builtin_amdgcn_mfma_f32_16x16x32_bf16(*(const LAS bf16x8_t*)(KG + (jt * 16 + fr) * 72 + kk * 32 + 8 * fq), *(const LAS bf16x8_t*)(QG + (it * 16 + fr) * 72 + kk * 32 + 8 * fq), acc, 0, 0, 0);
            const int i = it * 16 + fr, j0 = jt * 16 + 4 * fq;
            *(LAS u32x2_t*)(ATT + i * 40 + j0) = (u32x2_t){pk2(j0 <= i ? acc.x : 0.f, j0 + 1 <= i ? acc.y : 0.f), pk2(j0 + 2 <= i ? acc.z : 0.f, j0 + 3 <= i ? acc.w : 0.f)}; }
        LDS_BARRIER();
        {
            const int it = wave & 1, vtb = (wave >> 1) * 2;
#pragma unroll
            for (int q = 0; q < 2; ++q) { const int vt = vtb + q; f32x4 acc = (f32x4){0.f, 0.f, 0.f, 0.f};
#pragma unroll
                for (int kk = 0; kk < 2; ++kk) acc = __builtin_amdgcn_mfma_f32_16x16x32_bf16(*(const LAS bf16x8_t*)(QG + (it * 16 + fr) * 72 + kk * 32 + 8 * fq), *(const LAS bf16x8_t*)(ST + (vt * 16 + fr) * 72 + kk * 32 + 8 * fq), acc, 0, 0, 0);
                acc = __builtin_amdgcn_mfma_f32_16x16x32_bf16(*(const LAS bf16x8_t*)(ATT + (it * 16 + fr) * 40 + 8 * fq), *(const LAS bf16x8_t*)(VT + (vt * 16 + fr) * 40 + 8 * fq), acc, 0, 0, 0);
#pragma unroll
                for (int jj = 0; jj < 4; ++jj) OS[(it * 16 + 4 * fq + jj) * 132 + vt * 16 + fr] = acc[jj]; }
            const int kt = wave & 3, vt0 = (wave >> 2) * 4; const f32x4 glv = *(const LAS f32x4*)(GLS + kt * 16 + 4 * fq); const bf16x8_t xk = *(const LAS bf16x8_t*)(KDT + (kt * 16 + fr) * 40 + 8 * fq);
#pragma unroll
            for (int q = 0; q < 4; ++q) Sacc[q] = __builtin_amdgcn_mfma_f32_16x16x32_bf16(xk, *(const LAS bf16x8_t*)(VT + ((vt0 + q) * 16 + fr) * 40 + 8 * fq), Sacc[q] * glv, 0, 0, 0);
        }
        LDS_BARRIER();
        { const int kt = wave & 3, vt0 = (wave >> 2) * 4;
#pragma unroll
          for (int q = 0; q < 4; ++q) *(LAS u32x2_t*)(ST + ((vt0 + q) * 16 + fr) * 72 + kt * 16 + 4 * fq) = (u32x2_t){pk2(Sacc[q].x, Sacc[q].y), pk2(Sacc[q].z, Sacc[q].w)}; }
#pragma unroll
        for (int i = 0; i < 4; ++i) { const int t = wave * 4 + i; const f32x2 x = *((const LAS f32x2*)(OS + t * 132) + lane);
            const float r = frsq(wave_sum(x.x * x.x + x.y * x.y) * (1.f / 128.f) + NORM_EPS);
            *(unsigned*)(O + (rowb + t0 + t) * D + 512 + h * 128 + 2 * lane) = pk2(x.x * r * nw0 * silu(bflo(zg[i])), x.y * r * nw1 * silu(bfhi(zg[i]))); }
    }
    LDS_BARRIER();
#undef GLA2_PREFETCH
}
__device__ __forceinline__ void ssd_unit(LAS unsigned char* lds, int tid, int lane, int wave, int b, int hd, const bf16* PROJ, const float* SMALL, bf16* O,
                                         const float* convw, const float* convb, float dt_bias, float a_log, float dskip) {
    LAS float* xs = (LAS float*)lds; LAS float* Bs = xs + 4096; LAS float* Cs = Bs + 8192; LAS float* ys = Cs + 8192; LAS float* dts = ys + 4096; LAS float* das = dts + 64;
    const int p = tid >> 3, nq = tid & 7, g = hd >> 2;
    f32x2 Hs[8];
#pragma unroll
    for (int j = 0; j < 8; ++j) Hs[j] = (f32x2){0.f, 0.f};
    const int cp = tid % 160, th = tid / 160;
    const int xc = cp < 32 ? hd * 64 + 2 * cp : (cp < 96 ? 512 + g * 128 + 2 * (cp - 32) : 768 + g * 128 + 2 * (cp - 96));
    const int col = 512 + xc;
    float cw[4][2];
#pragma unroll
    for (int j = 0; j < 4; ++j) { cw[j][0] = convw[j * 1024 + xc]; cw[j][1] = convw[j * 1024 + xc + 1]; }
    const float cb0 = convb[xc], cb1 = convb[xc + 1];
    const float Aneg = -__expf(a_log);
    const size_t rowb = (size_t)b * SEQ;
    unsigned raw[35]; float dtr = 0.f;
#define SSD_PREFETCH(cn) do { const int ts_ = (cn) * 64 + th * 32; \
        if (tid < 320) { const bf16* pb_ = PROJ + (rowb + ts_) * PO + col; _Pragma("unroll") for (int j = 0; j < 35; ++j) { raw[j] = (j >= 3 || ts_ > 0) ? *(const unsigned*)(pb_ + (j - 3) * PO) : 0u; } } \
        else if (tid < 384) dtr = SMALL[(rowb + (cn) * 64 + (tid - 320)) * 32 + hd]; } while (0)
    SSD_PREFETCH(0);
    for (int c = 0; c < SEQ / 64; ++c) {
        const int t0 = c * 64;
        if (tid < 320) {
            LAS float* dst = (cp < 32 ? xs + (th * 32) * 64 + 2 * cp : (cp < 96 ? Bs + (th * 32) * 128 + 2 * (cp - 32) : Cs + (th * 32) * 128 + 2 * (cp - 96)));
            const int dstride = cp < 32 ? 64 : 128;
#pragma unroll
            for (int i = 0; i < 32; ++i) {
                const float y0 = cw[0][0] * bflo(raw[i]) + cw[1][0] * bflo(raw[i + 1]) + cw[2][0] * bflo(raw[i + 2]) + cw[3][0] * bflo(raw[i + 3]) + cb0;
                const float y1 = cw[0][1] * bfhi(raw[i]) + cw[1][1] * bfhi(raw[i + 1]) + cw[2][1] * bfhi(raw[i + 2]) + cw[3][1] * bfhi(raw[i + 3]) + cb1;
                *(LAS f32x2*)(dst + i * dstride) = (f32x2){silu(y0), silu(y1)};
            }
        } else if (tid < 384) { const int t = tid - 320; const float dt = softplus(dtr + dt_bias); dts[t] = dt; das[t] = __expf(dt * Aneg); }
        if (c + 1 < SEQ / 64) SSD_PREFETCH(c + 1);
        unsigned zg[4];
#pragma unroll
        for (int i = 0; i < 4; ++i) zg[i] = *(const unsigned*)(PROJ + (rowb + t0 + (tid >> 5)) * PO + hd * 64 + 2 * (tid & 31) + i * 16 * PO);
        LDS_BARRIER();
        {
            f32x4 bc[4], cc[4]; float cx = dts[0] * xs[p], da = das[0];
#pragma unroll
            for (int i = 0; i < 4; ++i) { bc[i] = *(const LAS f32x4*)(Bs + 4 * nq + 32 * i); cc[i] = *(const LAS f32x4*)(Cs + 4 * nq + 32 * i); }
#pragma unroll 2
            for (int t = 0; t < 64; ++t) {
                const int tn = t < 63 ? t + 1 : 63;
                f32x4 bn[4], cn[4]; const float cxn = dts[tn] * xs[tn * 64 + p], dan = das[tn];
#pragma unroll
                for (int i = 0; i < 4; ++i) { bn[i] = *(const LAS f32x4*)(Bs + tn * 128 + 4 * nq + 32 * i); cn[i] = *(const LAS f32x4*)(Cs + tn * 128 + 4 * nq + 32 * i); }
                f32x2 py = (f32x2){0.f, 0.f};
#pragma unroll
                for (int i = 0; i < 4; ++i) {
                    Hs[2 * i] = Hs[2 * i] * da + (f32x2){bc[i].x, bc[i].y} * cx; Hs[2 * i + 1] = Hs[2 * i + 1] * da + (f32x2){bc[i].z, bc[i].w} * cx;
                    py += Hs[2 * i] * (f32x2){cc[i].x, cc[i].y}; py += Hs[2 * i + 1] * (f32x2){cc[i].z, cc[i].w}; }
                const float y = red8(py.x + py.y);
                if (nq == 0) ys[t * 64 + p] = y;
#pragma unroll
                for (int i = 0; i < 4; ++i) { bc[i] = bn[i]; cc[i] = cn[i]; }
                cx = cxn; da = dan;
            }
        }
        LDS_BARRIER();
#pragma unroll
        for (int i = 0; i < 4; ++i) { const int e = tid + i * NT, t = e >> 5, pp = e & 31; const f32x2 yv = *(const LAS f32x2*)(ys + t * 64 + 2 * pp), xv = *(const LAS f32x2*)(xs + t * 64 + 2 * pp);
            *(unsigned*)(O + (rowb + t0 + t) * D + hd * 64 + 2 * pp) = pk2((yv.x + xv.x * dskip) * silu(bflo(zg[i])), (yv.y + xv.y * dskip) * silu(bfhi(zg[i]))); }
        LDS_BARRIER();
    }
#undef SSD_PREFETCH
}
__device__ __forceinline__ void ssd_fix(bf16* O, const float* w, int gw, int NGW, int lane) {
    f32x4 w0 = *((const f32x4*)w + 2 * lane), w1 = *((const f32x4*)w + 2 * lane + 1);
    for (int m = gw; m < M; m += NGW) {
        v4u* p = (v4u*)(O + (size_t)m * D) + lane; const v4u u = *p;
        float x[8] = {bflo(u.x), bfhi(u.x), bflo(u.y), bfhi(u.y), bflo(u.z), bfhi(u.z), bflo(u.w), bfhi(u.w)};
        float s = 0.f;
#pragma unroll
        for (int j = 0; j < 8; ++j) s += x[j] * x[j];
        s = half_sum(s, lane);
        const float r = frsq(s * (1.f / 256.f) + NORM_EPS);
        v4u o; o.x = pk2(x[0] * r * w0.x, x[1] * r * w0.y); o.y = pk2(x[2] * r * w0.z, x[3] * r * w0.w); o.z = pk2(x[4] * r * w1.x, x[5] * r * w1.y); o.w = pk2(x[6] * r * w1.z, x[7] * r * w1.w);
        *p = o;
    }
}
struct RwkvW { const float *mu, *w0, *w2, *a0, *a2, *g2, *k_k, *k_a, *r_k, *gn_w, *gn_b; };
__device__ __forceinline__ void rwkv_unit(LAS unsigned char* lds, int tid, int lane, int wave, int b, int hd, const bf16* PROJ, bf16* O, const RwkvW W) {
    LAS float* rs = (LAS float*)lds; LAS float* wsd = rs + 2048; LAS float* kks = wsd + 2048; LAS float* vvs = kks + 2048; LAS float* aas = vvs + 2048; LAS float* bbs = aas + 2048;
    LAS float* gs = bbs + 2048; LAS float* ys = gs + 2048;
    LAS bf16* xw = (LAS bf16*)(lds + 65536); LAS bf16* xa = xw + 32 * 72; LAS bf16* xg = xa + 32 * 72;
    LAS bf16* w2t = xg + 32 * 136; LAS bf16* a2t = w2t + 64 * 72; LAS bf16* g2t = a2t + 64 * 72;
    const int vp = tid >> 4, kq = tid & 15;
    f32x2 S0[2], S1[2];
#pragma unroll
    for (int j = 0; j < 2; ++j) { S0[j] = (f32x2){0.f, 0.f}; S1[j] = (f32x2){0.f, 0.f}; }
    const int ch = tid & 63, tg = tid >> 6, cc = hd * 64 + ch;
    const float w0c = W.w0[cc], a0c = W.a0[cc], kkc = W.k_k[cc], kac = W.k_a[cc], rkc = W.r_k[cc], gnw = W.gn_w[cc], gnb = W.gn_b[cc];
    const size_t rowb = (size_t)b * SEQ;
#pragma unroll
    for (int e = tid; e < 4096; e += NT) { const int j = e >> 6, c1 = e & 63; w2t[c1 * 72 + j] = (bf16)f2bf(W.w2[j * 512 + hd * 64 + c1]); a2t[c1 * 72 + j] = (bf16)f2bf(W.a2[j * 512 + hd * 64 + c1]); }
#pragma unroll
    for (int e = tid; e < 8192; e += NT) { const int j = e >> 6, c1 = e & 63; g2t[c1 * 136 + j] = (bf16)f2bf(W.g2[j * 512 + hd * 64 + c1]); }
    const int pp = tid & 255, tq = tid >> 8;
    int dc = 0, kind = 0, loff = 0;
    if (pp < 32) { dc = hd * 64 + 2 * pp; loff = 2 * pp; } else if (pp < 64) { dc = 512 + hd * 64 + 2 * (pp - 32); loff = 2 * (pp - 32); } else if (pp < 96) { dc = 1024 + hd * 64 + 2 * (pp - 64); loff = 2 * (pp - 64); }
    else if (pp < 128) { dc = 1600 + 2 * (pp - 96); loff = 2 * (pp - 96); kind = 2; } else if (pp < 160) { dc = 1536 + 2 * (pp - 128); loff = 2 * (pp - 128); kind = 1; } else if (pp < 224) { dc = 1664 + 2 * (pp - 160); loff = 2 * (pp - 160); kind = 3; }
    LAS float* fdst = pp < 32 ? rs : (pp < 64 ? kks : vvs);
    const float m0 = W.mu[dc], m1 = W.mu[dc + 1];
    const float sB = kind == 1 ? 2.f : 1.f, sC = kind == 1 ? -1.f : 0.f;
    unsigned raw[17];
#define RWKV_PREFETCH(cn) do { if (pp < 224) { const int ts_ = (cn) * 32 + tq * 16; \
        const bf16* pb_ = PROJ + (rowb + ts_) * PO + 1536 + dc; _Pragma("unroll") for (int j = 0; j < 17; ++j) { raw[j] = (j >= 1 || ts_ > 0) ? *(const unsigned*)(pb_ + (j - 1) * PO) : 0u; } } } while (0)
    RWKV_PREFETCH(0);
    const int fr = lane & 15, fq = lane >> 4, mt = wave & 1, mc = wave >> 1;
    for (int c = 0; c < SEQ / 32; ++c) {
        const int t0 = c * 32;
        if (pp < 224) {
            LAS bf16* bdst = kind == 1 ? xw + loff : xg + loff; const int bstr = kind == 1 ? 72 : 136;
#pragma unroll
            for (int i = 0; i < 16; ++i) { const int t = tq * 16 + i;
                float y0 = bflo(raw[i + 1]), y1 = bfhi(raw[i + 1]); y0 += (bflo(raw[i]) - y0) * m0; y1 += (bfhi(raw[i]) - y1) * m1;
                if (kind == 0) *(LAS f32x2*)(fdst + t * 64 + loff) = (f32x2){y0, y1};
                else if (kind == 2) *(LAS unsigned*)(xa + t * 72 + loff) = pk2(y0, y1);
                else *(LAS unsigned*)(bdst + t * bstr) = pk2(sB * sigm(sB * y0) + sC, sB * sigm(sB * y1) + sC); }
        }
        if (c + 1 < SEQ / 32) RWKV_PREFETCH(c + 1);
        LDS_BARRIER();
        {
            f32x4 accw = (f32x4){0.f, 0.f, 0.f, 0.f}, acca = accw, accg = accw;
#pragma unroll
            for (int kk = 0; kk < 2; ++kk) {
                const bf16x8_t xf = *(const LAS bf16x8_t*)(xw + (mt * 16 + fr) * 72 + kk * 32 + 8 * fq), wf = *(const LAS bf16x8_t*)(w2t + (mc * 16 + fr) * 72 + kk * 32 + 8 * fq);
                accw = __builtin_amdgcn_mfma_f32_16x16x32_bf16(wf, xf, accw, 0, 0, 0);
                const bf16x8_t xf2 = *(const LAS bf16x8_t*)(xa + (mt * 16 + fr) * 72 + kk * 32 + 8 * fq), wf2 = *(const LAS bf16x8_t*)(a2t + (mc * 16 + fr) * 72 + kk * 32 + 8 * fq);
                acca = __builtin_amdgcn_mfma_f32_16x16x32_bf16(wf2, xf2, acca, 0, 0, 0); }
#pragma unroll
            for (int kk = 0; kk < 4; ++kk) {
                const bf16x8_t xf = *(const LAS bf16x8_t*)(xg + (mt * 16 + fr) * 136 + kk * 32 + 8 * fq), wf = *(const LAS bf16x8_t*)(g2t + (mc * 16 + fr) * 136 + kk * 32 + 8 * fq);
                accg = __builtin_amdgcn_mfma_f32_16x16x32_bf16(wf, xf, accg, 0, 0, 0); }
            const int o = (mt * 16 + fr) * 64 + mc * 16 + 4 * fq;
            *(LAS f32x4*)(wsd + o) = accw; *(LAS f32x4*)(aas + o) = acca; *(LAS f32x4*)(gs + o) = accg;
        }
        LDS_BARRIER();
#pragma unroll
        for (int i = 0; i < 4; ++i) { const int idx = (tg * 4 + i) * 64 + ch;
            const float wlog = -softplus(-(wsd[idx] + w0c)) - 0.5f, decay = __expf(-__expf(wlog)), a = sigm(aas[idx] + a0c);
            const float kraw = kks[idx], kkv = kraw * kkc; const float kkn = kkv * (frsq(wave_sum(kkv * kkv) + L2_EPS));
            wsd[idx] = decay; kks[idx] = kraw * (1.f + (a - 1.f) * kac); aas[idx] = -kkn; bbs[idx] = kkn * a; }
        LDS_BARRIER();
        {
            const int o = 4 * kq;
            f32x4 ac = *(const LAS f32x4*)(aas + o), wc = *(const LAS f32x4*)(wsd + o), bc = *(const LAS f32x4*)(bbs + o), kc = *(const LAS f32x4*)(kks + o), rc = *(const LAS f32x4*)(rs + o);
            float v0 = vvs[vp], v1 = vvs[vp + 32];
#pragma unroll 2
            for (int t = 0; t < 32; ++t) {
                const int tn = t < 31 ? t + 1 : 31, on = tn * 64 + 4 * kq;
                const f32x4 an = *(const LAS f32x4*)(aas + on), wn = *(const LAS f32x4*)(wsd + on), bn = *(const LAS f32x4*)(bbs + on), kn = *(const LAS f32x4*)(kks + on), rn = *(const LAS f32x4*)(rs + on);
                const float v0n = vvs[tn * 64 + vp], v1n = vvs[tn * 64 + vp + 32];
                const f32x2 alo = (f32x2){ac.x, ac.y}, ahi = (f32x2){ac.z, ac.w}, wlo = (f32x2){wc.x, wc.y}, whi = (f32x2){wc.z, wc.w}, blo = (f32x2){bc.x, bc.y}, bhi = (f32x2){bc.z, bc.w};
                const f32x2 klo = (f32x2){kc.x, kc.y}, khi = (f32x2){kc.z, kc.w}, rlo = (f32x2){rc.x, rc.y}, rhi = (f32x2){rc.z, rc.w};
                const f32x2 p0 = S0[0] * alo + S0[1] * ahi, p1 = S1[0] * alo + S1[1] * ahi;
                const float sa0 = red16(p0.x + p0.y), sa1 = red16(p1.x + p1.y);
                S0[0] = S0[0] * wlo + (blo * sa0 + klo * v0); S0[1] = S0[1] * whi + (bhi * sa0 + khi * v0);
                S1[0] = S1[0] * wlo + (blo * sa1 + klo * v1); S1[1] = S1[1] * whi + (bhi * sa1 + khi * v1);
                const f32x2 q0 = S0[0] * rlo + S0[1] * rhi, q1 = S1[0] * rlo + S1[1] * rhi;
                const float y0 = red16(q0.x + q0.y), y1 = red16(q1.x + q1.y);
                if (kq == 0) { ys[t * 64 + vp] = y0; ys[t * 64 + vp + 32] = y1; }
                ac = an; wc = wn; bc = bn; kc = kn; rc = rn; v0 = v0n; v1 = v1n;
            }
        }
        LDS_BARRIER();
#pragma unroll
        for (int i = 0; i < 4; ++i) { const int t = wave * 4 + i; const int idx = t * 64 + lane; const float y = ys[idx];
            const float mean = wave_sum(y) * (1.f / 64.f), d = y - mean, var = wave_sum(d * d) * (1.f / 64.f);
            const float yn = d * (frsq(var + 64e-5f)) * gnw + gnb;
            const float rk = wave_sum(rs[idx] * kks[idx] * rkc);
            O[(rowb + t0 + t) * D + 512 + hd * 64 + lane] = (bf16)f2bf((yn + rk * vvs[idx]) * gs[idx]); }
        LDS_BARRIER();
    }
#undef RWKV_PREFETCH
}
__device__ __forceinline__ void ssd_chunked(LAS unsigned char* lds, int tid_in, int wave_in, int b, int hd, const bf16* PROJ, const float* SMALL, bf16* O,
                                            const float* convw, const float* convb, float dt_bias, float a_log, float dskip) {
    LAS bf16* Cb = (LAS bf16*)(lds + 0); LAS bf16* CG = (LAS bf16*)(lds + 8704); LAS bf16* Bb = (LAS bf16*)(lds + 17408);
    LAS bf16* BDT = (LAS bf16*)(lds + 26112);
    LAS bf16* XDT = (LAS bf16*)(lds + 36352);
    LAS bf16* ATT = (LAS bf16*)(lds + 41472);
    LAS bf16* ST = (LAS bf16*)(lds + 44032);
    LAS float* YS = (LAS float*)(lds + 61440);
    LAS float* XS = (LAS float*)(lds + 70144);
    LAS float* acs = (LAS float*)(lds + 78336); LAS float* eac = acs + 32; LAS float* dtv = eac + 32; LAS float* ekd = dtv + 32; LAS float* gls = ekd + 32;
    const int g = hd >> 2;
    f32x4 Sacc[4];
#pragma unroll
    for (int j = 0; j < 4; ++j) Sacc[j] = (f32x4){0.f, 0.f, 0.f, 0.f};
    for (int e = tid_in; e < 64 * 136 / 2; e += NT) ((LAS unsigned*)ST)[e] = 0u;
    const int cp0 = tid_in % 160, th0 = tid_in / 160;
    const int xc = cp0 < 32 ? hd * 64 + 2 * cp0 : (cp0 < 96 ? 512 + g * 128 + 2 * (cp0 - 32) : 768 + g * 128 + 2 * (cp0 - 96));
    const int col = 512 + xc;
    float cw[4][2];
#pragma unroll
    for (int j = 0; j < 4; ++j) { cw[j][0] = convw[j * 1024 + xc]; cw[j][1] = convw[j * 1024 + xc + 1]; }
    const float cb0 = convb[xc], cb1 = convb[xc + 1];
    const float Aneg = -__expf(a_log);
    const size_t rowb = (size_t)b * SEQ;
    unsigned raw[19]; float dtr = 0.f;
#define SSD2_PREFETCH(cn) do { const int ts_ = (cn) * 32 + th0 * 16; \
        if (tid_in < 320) { const bf16* pb_ = PROJ + (rowb + ts_) * PO + col; _Pragma("unroll") for (int j = 0; j < 19; ++j) { raw[j] = (j >= 3 || ts_ > 0) ? *(const unsigned*)(pb_ + (j - 3) * PO) : 0u; } } \
        else if (tid_in < 352) dtr = SMALL[(rowb + (cn) * 32 + (tid_in - 320)) * 32 + hd]; } while (0)
    SSD2_PREFETCH(0);
    LDS_BARRIER();
    for (int c = 0; c < SEQ / 32; ++c) {
        int tid_l = tid_in, wave_l = wave_in; asm volatile("" : "+v"(tid_l), "+s"(wave_l));
        const int tid = tid_l, wave = wave_l, lane = tid & 63, fr = lane & 15, fq = lane >> 4, cp = tid % 160, th = tid / 160;
        const int t0 = c * 32;
        float y0[16], y1[16];
        if (tid < 320) {
            f32x2 xv[19];
#pragma unroll
            for (int j = 0; j < 19; ++j) xv[j] = (f32x2){bflo(raw[j]), bfhi(raw[j])};
            const f32x2 c0v = {cw[0][0], cw[0][1]}, c1v = {cw[1][0], cw[1][1]}, c2v = {cw[2][0], cw[2][1]}, c3v = {cw[3][0], cw[3][1]}, cbv = {cb0, cb1};
#pragma unroll
            for (int i = 0; i < 16; ++i) { const f32x2 yv = silu2(((c0v * xv[i] + cbv) + c1v * xv[i + 1]) + (c2v * xv[i + 2] + c3v * xv[i + 3])); y0[i] = yv.x; y1[i] = yv.y; }
        } else if (tid < 384) {
            const float dt = softplus(dtr + dt_bias); float a = dt * Aneg;
#pragma unroll
            for (int o = 1; o < 32; o <<= 1) { const float t_ = __shfl_up(a, o); if ((lane & 31) >= o) a += t_; }
            const float al = __shfl(a, 31);
            if (lane < 32) { acs[lane] = a; eac[lane] = __expf(a); dtv[lane] = dt; ekd[lane] = __expf(al - a); if (lane == 0) gls[0] = __expf(al); }
        }
        if (c + 1 < SEQ / 32) SSD2_PREFETCH(c + 1);
        unsigned zg[2];
#pragma unroll
        for (int i = 0; i < 2; ++i) zg[i] = *(const unsigned*)(PROJ + (rowb + t0 + (tid >> 5)) * PO + hd * 64 + 2 * (tid & 31) + i * 16 * PO);
        LDS_BARRIER();
        if (tid < 320) {
#define SSD2_T16(dst0, dst1) _Pragma("unroll") for (int h8 = 0; h8 < 2; ++h8) { \
                *(LAS v4u*)((dst0) + th * 16 + 8 * h8) = (v4u){pk2(e0[8 * h8], e0[8 * h8 + 1]), pk2(e0[8 * h8 + 2], e0[8 * h8 + 3]), pk2(e0[8 * h8 + 4], e0[8 * h8 + 5]), pk2(e0[8 * h8 + 6], e0[8 * h8 + 7])}; \
                *(LAS v4u*)((dst1) + th * 16 + 8 * h8) = (v4u){pk2(e1[8 * h8], e1[8 * h8 + 1]), pk2(e1[8 * h8 + 2], e1[8 * h8 + 3]), pk2(e1[8 * h8 + 4], e1[8 * h8 + 5]), pk2(e1[8 * h8 + 6], e1[8 * h8 + 7])}; }
            float e0[16], e1[16];
            if (cp < 32) {
#pragma unroll
                for (int i = 0; i < 16; ++i) { const int r = th * 16 + i; const float dt = dtv[r]; *(LAS f32x2*)(XS + r * 64 + 2 * cp) = (f32x2){y0[i], y1[i]}; e0[i] = y0[i] * dt; e1[i] = y1[i] * dt; }
                SSD2_T16(XDT + (2 * cp) * 40, XDT + (2 * cp + 1) * 40)
            } else if (cp < 96) { const int n = 2 * (cp - 32);
#pragma unroll
                for (int i = 0; i < 16; ++i) { const int r = th * 16 + i; const float ek = ekd[r]; *(LAS unsigned*)(Bb + r * 136 + n) = pk2(y0[i], y1[i]); e0[i] = y0[i] * ek; e1[i] = y1[i] * ek; }
                SSD2_T16(BDT + n * 40, BDT + (n + 1) * 40)
            } else { const int n = 2 * (cp - 96);
#pragma unroll
                for (int i = 0; i < 16; ++i) { const int r = th * 16 + i; const float ea = eac[r]; *(LAS unsigned*)(Cb + r * 136 + n) = pk2(y0[i], y1[i]); *(LAS unsigned*)(CG + r * 136 + n) = pk2(y0[i] * ea, y1[i] * ea); }
            }
#undef SSD2_T16
        }
        LDS_BARRIER();
        if (wave < 4) { const int it = wave >> 1, jt = wave & 1; f32x4 acc = (f32x4){0.f, 0.f, 0.f, 0.f};
#pragma unroll
            for (int kk = 0; kk < 4; ++kk) acc = __builtin_amdgcn_mfma_f32_16x16x32_bf16(*(const LAS bf16x8_t*)(Bb + (jt * 16 + fr) * 136 + kk * 32 + 8 * fq), *(const LAS bf16x8_t*)(Cb + (it * 16 + fr) * 136 + kk * 32 + 8 * fq), acc, 0, 0, 0);
            const int i = it * 16 + fr, j0 = jt * 16 + 4 * fq; const float ai = acs[i]; const f32x4 aj = *(const LAS f32x4*)(acs + j0);
            float o4[4];
#pragma unroll
            for (int jj = 0; jj < 4; ++jj) o4[jj] = (j0 + jj <= i) ? acc[jj] * __expf(ai - aj[jj]) : 0.f;
            *(LAS u32x2_t*)(ATT + i * 40 + j0) = (u32x2_t){pk2(o4[0], o4[1]), pk2(o4[2], o4[3])}; }
        LDS_BARRIER();
        {
            const int it = wave & 1, pt = wave >> 1; f32x4 acc = (f32x4){0.f, 0.f, 0.f, 0.f};
#pragma unroll
            for (int kk = 0; kk < 4; ++kk) acc = __builtin_amdgcn_mfma_f32_16x16x32_bf16(*(const LAS bf16x8_t*)(CG + (it * 16 + fr) * 136 + kk * 32 + 8 * fq), *(const LAS bf16x8_t*)(ST + (pt * 16 + fr) * 136 + kk * 32 + 8 * fq), acc, 0, 0, 0);
            acc = __builtin_amdgcn_mfma_f32_16x16x32_bf16(*(const LAS bf16x8_t*)(ATT + (it * 16 + fr) * 40 + 8 * fq), *(const LAS bf16x8_t*)(XDT + (pt * 16 + fr) * 40 + 8 * fq), acc, 0, 0, 0);
#pragma unroll
            for (int jj = 0; jj < 4; ++jj) YS[(it * 16 + 4 * fq + jj) * 68 + pt * 16 + fr] = acc[jj];
            const float gl = gls[0]; const bf16x8_t xb = *(const LAS bf16x8_t*)(BDT + (wave * 16 + fr) * 40 + 8 * fq);
#pragma unroll
            for (int q = 0; q < 4; ++q) Sacc[q] = __builtin_amdgcn_mfma_f32_16x16x32_bf16(xb, *(const LAS bf16x8_t*)(XDT + (q * 16 + fr) * 40 + 8 * fq), Sacc[q] * gl, 0, 0, 0);
        }
        LDS_BARRIER();
#pragma unroll
        for (int q = 0; q < 4; ++q) *(LAS u32x2_t*)(ST + (q * 16 + fr) * 136 + wave * 16 + 4 * fq) = (u32x2_t){pk2(Sacc[q].x, Sacc[q].y), pk2(Sacc[q].z, Sacc[q].w)};
#pragma unroll
        for (int i = 0; i < 2; ++i) { const int t = (tid >> 5) + 16 * i, pp = tid & 31; const f32x2 yv = *(const LAS f32x2*)(YS + t * 68 + 2 * pp), xv = *(const LAS f32x2*)(XS + t * 64 + 2 * pp);
            *(unsigned*)(O + (rowb + t0 + t) * D + hd * 64 + 2 * pp) = pk2((yv.x + xv.x * dskip) * silu(bflo(zg[i])), (yv.y + xv.y * dskip) * silu(bfhi(zg[i]))); }
    }
    LDS_BARRIER();
#undef SSD2_PREFETCH
}
constexpr int RI_GP = 0, RI_HAT = 9216, RI_RT = 18432, RI_RKV = 27648, RI_GG = 35840, RI_WCC = 44032, RI_BYTES = 44288;
__device__ __forceinline__ void rwkv_phase_a(LAS unsigned char* lds, int tid_in, int wave_in, int first, int stride, const bf16* PROJ, bf16* O, unsigned char* RS, const RwkvW W) {
    LAS bf16* w2t = (LAS bf16*)(lds + 0); LAS bf16* a2t = (LAS bf16*)(lds + 9216); LAS bf16* g2t = (LAS bf16*)(lds + 18432);
    LAS float* rs = (LAS float*)(lds + 35840); LAS float* kks = (LAS float*)(lds + 52224); LAS float* vvs = (LAS float*)(lds + 68608);
    LAS bf16* xw = (LAS bf16*)(lds + 84992); LAS bf16* xa = (LAS bf16*)(lds + 94208); LAS bf16* xg = (LAS bf16*)(lds + 103424);
    LAS float* WL = (LAS float*)(lds + 84992); LAS bf16* AL = (LAS bf16*)(lds + 101376); LAS bf16* GL = (LAS bf16*)(lds + 109568);
    LAS float* SEG = (LAS float*)(lds + 120832);
    LAS bf16* AT = (LAS bf16*)(lds + 35840); LAS bf16* BT = (LAS bf16*)(lds + 45056); LAS bf16* KT = (LAS bf16*)(lds + 54272); LAS bf16* RTn = (LAS bf16*)(lds + 63488);
    LAS bf16* BTT = (LAS bf16*)(lds + 72704); LAS bf16* KTT = (LAS bf16*)(lds + 81920); LAS bf16* VTT = (LAS bf16*)(lds + 91136);
    LAS float* Lf = (LAS float*)(lds + 100352); LAS bf16* MAK = (LAS bf16*)(lds + 117760); LAS bf16* NRB = (LAS bf16*)(lds + 126976); LAS bf16* NRK = (LAS bf16*)(lds + 136192);
    LAS float* WCCL = (LAS float*)(lds + 145408);
    LAS float* RHSUT = (LAS float*)(lds + 45056);
    LAS bf16* U0T = (LAS bf16*)(lds + 35840); LAS bf16* WTT = (LAS bf16*)(lds + 45056);
    int cur_hd = -1; float m0 = 0.f, m1 = 0.f;
    unsigned raw[33];
#ifndef RWKVA_NITEMS
#define RWKVA_NITEMS 4096
#endif
#define RWKVA_ITEM(item, c_, hd_, b_) const int c_ = (item) & 31, hd_ = ((item) >> 5) & 7, b_ = ((item) & 4095) >> 8
#define RWKVA_DC(pp_, hd_) ((pp_) < 32 ? (hd_) * 64 + 2 * (pp_) : (pp_) < 64 ? 512 + (hd_) * 64 + 2 * ((pp_) - 32) : (pp_) < 96 ? 1024 + (hd_) * 64 + 2 * ((pp_) - 64) : (pp_) < 128 ? 1600 + 2 * ((pp_) - 96) : (pp_) < 160 ? 1536 + 2 * ((pp_) - 128) : 1664 + 2 * ((pp_) - 160))
#define RWKVA_PREFETCH(item) do { RWKVA_ITEM(item, c__, hd__, b__); const int pp_ = tid_in & 255, tq_ = tid_in >> 8; if (pp_ < 224) { const int ts_ = c__ * 64 + tq_ * 32; \
        const bf16* pb_ = PROJ + ((size_t)b__ * SEQ + ts_) * PO + 1536 + RWKVA_DC(pp_, hd__); _Pragma("unroll") for (int j = 0; j < 33; ++j) { raw[j] = (j >= 1 || ts_ > 0) ? *(const unsigned*)(pb_ + (j - 1) * PO) : 0u; } } } while (0)
    if (first < RWKVA_NITEMS) RWKVA_PREFETCH(first);
    for (int item = first; item < RWKVA_NITEMS; item += stride) {
        int tid_l = tid_in, wave_l = wave_in; asm volatile("" : "+v"(tid_l), "+s"(wave_l));
        const int tid = tid_l, wave = wave_l, lane = tid & 63, fr = lane & 15, fq = lane >> 4;
        RWKVA_ITEM(item, c, hd, b);
        const size_t rowb = (size_t)b * SEQ + c * 64;
        unsigned char* img = RS + (size_t)(item & 4095) * RI_BYTES;
        if (hd != cur_hd) {
            LDS_BARRIER();
#pragma unroll
            for (int e = tid; e < 4096; e += NT) { const int j = e >> 6, c1 = e & 63; w2t[c1 * 72 + j] = (bf16)f2bf(W.w2[j * 512 + hd * 64 + c1]); a2t[c1 * 72 + j] = (bf16)f2bf(W.a2[j * 512 + hd * 64 + c1]); }
#pragma unroll
            for (int e = tid; e < 8192; e += NT) { const int j = e >> 6, c1 = e & 63; g2t[c1 * 136 + j] = (bf16)f2bf(W.g2[j * 512 + hd * 64 + c1]); }
            { const int pp_ = tid & 255; if (pp_ < 224) { const int dc_ = RWKVA_DC(pp_, hd); m0 = W.mu[dc_]; m1 = W.mu[dc_ + 1]; } }
            cur_hd = hd;
        }
        { const int pp = tid & 255, tq = tid >> 8;
          if (pp < 224) {
            const int kind = pp < 96 ? 0 : (pp < 128 ? 2 : (pp < 160 ? 1 : 3));
            const int loff = pp < 32 ? 2 * pp : pp < 64 ? 2 * (pp - 32) : pp < 96 ? 2 * (pp - 64) : pp < 128 ? 2 * (pp - 96) : pp < 160 ? 2 * (pp - 128) : 2 * (pp - 160);
            LAS float* fdst = pp < 32 ? rs : (pp < 64 ? kks : vvs);
            const float sB = kind == 1 ? 2.f : 1.f, sC = kind == 1 ? -1.f : 0.f;
            LAS bf16* bdst = kind == 1 ? xw + loff : xg + loff; const int bstr = kind == 1 ? 72 : 136;
#define RWKVA_MIX(i) const int t = tq * 32 + (i); float y0 = bflo(raw[(i) + 1]), y1 = bfhi(raw[(i) + 1]); y0 += (bflo(raw[(i)]) - y0) * m0; y1 += (bfhi(raw[(i)]) - y1) * m1
            if (kind == 0) {
#pragma unroll
                for (int i = 0; i < 32; ++i) { RWKVA_MIX(i); *(LAS f32x2*)(fdst + t * 64 + loff) = (f32x2){y0, y1}; }
            } else if (kind == 2) {
#pragma unroll
                for (int i = 0; i < 32; ++i) { RWKVA_MIX(i); *(LAS unsigned*)(xa + t * 72 + loff) = pk2(y0, y1); }
            } else {
#pragma unroll
                for (int i = 0; i < 32; ++i) { RWKVA_MIX(i); *(LAS unsigned*)(bdst + t * bstr) = pk2(sB * sigm(sB * y0) + sC, sB * sigm(sB * y1) + sC); }
            }
#undef RWKVA_MIX
          } }
        if (item + stride < RWKVA_NITEMS) RWKVA_PREFETCH(item + stride);
        const int cc = hd * 64 + lane;
        const float w0c = W.w0[cc], a0c = W.a0[cc], kkc = W.k_k[cc], kac = W.k_a[cc], rkc = W.r_k[cc];
        LDS_BARRIER();
        f32x4 rw[2], ra[2], rg[2];
        { const int tt = wave >> 1;
#pragma unroll
          for (int q = 0; q < 2; ++q) { const int ct = (wave & 1) * 2 + q; f32x4 accw = (f32x4){0.f, 0.f, 0.f, 0.f}, acca = accw, accg = accw;
#pragma unroll
            for (int kk = 0; kk < 2; ++kk) {
                accw = __builtin_amdgcn_mfma_f32_16x16x32_bf16(*(const LAS bf16x8_t*)(w2t + (ct * 16 + fr) * 72 + kk * 32 + 8 * fq), *(const LAS bf16x8_t*)(xw + (tt * 16 + fr) * 72 + kk * 32 + 8 * fq), accw, 0, 0, 0);
                acca = __builtin_amdgcn_mfma_f32_16x16x32_bf16(*(const LAS bf16x8_t*)(a2t + (ct * 16 + fr) * 72 + kk * 32 + 8 * fq), *(const LAS bf16x8_t*)(xa + (tt * 16 + fr) * 72 + kk * 32 + 8 * fq), acca, 0, 0, 0); }
#pragma unroll
            for (int kk = 0; kk < 4; ++kk) accg = __builtin_amdgcn_mfma_f32_16x16x32_bf16(*(const LAS bf16x8_t*)(g2t + (ct * 16 + fr) * 136 + kk * 32 + 8 * fq), *(const LAS bf16x8_t*)(xg + (tt * 16 + fr) * 136 + kk * 32 + 8 * fq), accg, 0, 0, 0);
            rw[q] = accw; ra[q] = acca; rg[q] = accg; } }
        LDS_BARRIER();
        { const int tt = wave >> 1;
#pragma unroll
          for (int q = 0; q < 2; ++q) { const int ct = (wave & 1) * 2 + q; const int o = (tt * 16 + fr) * 64 + ct * 16 + 4 * fq;
            *(LAS f32x4*)(WL + o) = rw[q]; *(LAS u32x2_t*)(AL + o) = (u32x2_t){pk2(ra[q].x, ra[q].y), pk2(ra[q].z, ra[q].w)}; const u32x2_t gpk = (u32x2_t){pk2(rg[q].x, rg[q].y), pk2(rg[q].z, rg[q].w)}; *(u32x2_t*)((bf16*)(img + RI_GG) + o) = gpk; } }
        LDS_BARRIER();
        float lw[8], av[8], kn[8], km[8], rr[8], vv[8];
        bf16* prkv = (bf16*)(img + RI_RKV) + wave * 512 + lane;
#pragma unroll
        for (int i = 0; i < 8; ++i) { const int t = wave * 8 + i, idx = t * 64 + lane;
            const float wlog = -softplus(-(WL[idx] + w0c)) - 0.5f; lw[i] = -__expf(wlog);
            const float a = sigm(bflo((unsigned)AL[idx]) + a0c), kraw = kks[idx], kkv = kraw * kkc;
            kn[i] = kkv * frsq(wave_sum(kkv * kkv) + L2_EPS); km[i] = kraw * (1.f + (a - 1.f) * kac); av[i] = a; rr[i] = rs[idx]; vv[i] = vvs[idx];
            const float rk = wave_sum(rr[i] * km[i] * rkc);
            prkv[i * 64] = (bf16)f2bf(rk * vv[i]); }
#pragma unroll
        for (int i = 1; i < 8; ++i) lw[i] += lw[i - 1];
        SEG[wave * 64 + lane] = lw[7];
        LDS_BARRIER();
        { float off = 0.f, tot = 0.f;
#pragma unroll
          for (int w2 = 0; w2 < 8; ++w2) { const float sgm = SEG[w2 * 64 + lane]; tot += sgm; if (w2 < wave) off += sgm; }
          const float wcc = __expf(tot);
          if (wave == 0) { WCCL[lane] = wcc; ((float*)(img + RI_WCC))[lane] = wcc; }
#pragma unroll
          for (int i = 0; i < 8; ++i) { const int t = wave * 8 + i; const float cs = off + lw[i], csx = i ? off + lw[i - 1] : off;
            const float Wc = __expf(cs), Wx = __expf(csx), iW = __expf(-cs);
            const float bbf = kn[i] * av[i] * iW, kbf = km[i] * iW;
            AT[t * 72 + lane] = (bf16)f2bf(-kn[i] * Wx); BT[t * 72 + lane] = (bf16)f2bf(bbf); KT[t * 72 + lane] = (bf16)f2bf(kbf); RTn[t * 72 + lane] = (bf16)f2bf(rr[i] * Wc);
            av[i] = bbf; km[i] = kbf; }
          *(LAS v4u*)(BTT + lane * 72 + wave * 8) = (v4u){pk2(av[0], av[1]), pk2(av[2], av[3]), pk2(av[4], av[5]), pk2(av[6], av[7])};
          *(LAS v4u*)(KTT + lane * 72 + wave * 8) = (v4u){pk2(km[0], km[1]), pk2(km[2], km[3]), pk2(km[4], km[5]), pk2(km[6], km[7])};
          *(LAS v4u*)(VTT + lane * 72 + wave * 8) = (v4u){pk2(vv[0], vv[1]), pk2(vv[2], vv[3]), pk2(vv[4], vv[5]), pk2(vv[6], vv[7])}; }
        LDS_BARRIER();
#if defined(RWKVA_HALFPROBE)
        if (item >= 4096) continue;
#endif
        { const int tt = wave >> 1, t = tt * 16 + fr;
#pragma unroll
          for (int q = 0; q < 2; ++q) { const int jt = (wave & 1) * 2 + q, j0 = jt * 16 + 4 * fq;
            f32x4 mab = (f32x4){0.f, 0.f, 0.f, 0.f}, mak = mab, nrb = mab, nrk = mab;
            if (jt <= tt) {
#pragma unroll
                for (int kk = 0; kk < 2; ++kk) { const bf16x8_t bx_ = *(const LAS bf16x8_t*)(BT + (jt * 16 + fr) * 72 + kk * 32 + 8 * fq), kx_ = *(const LAS bf16x8_t*)(KT + (jt * 16 + fr) * 72 + kk * 32 + 8 * fq);
                    const bf16x8_t ay_ = *(const LAS bf16x8_t*)(AT + t * 72 + kk * 32 + 8 * fq), ry_ = *(const LAS bf16x8_t*)(RTn + t * 72 + kk * 32 + 8 * fq);
                    mab = __builtin_amdgcn_mfma_f32_16x16x32_bf16(bx_, ay_, mab, 0, 0, 0); mak = __builtin_amdgcn_mfma_f32_16x16x32_bf16(kx_, ay_, mak, 0, 0, 0);
                    nrb = __builtin_amdgcn_mfma_f32_16x16x32_bf16(bx_, ry_, nrb, 0, 0, 0); nrk = __builtin_amdgcn_mfma_f32_16x16x32_bf16(kx_, ry_, nrk, 0, 0, 0); } }
            float l4[4], m4[4], b4[4], k4[4];
#pragma unroll
            for (int jj = 0; jj < 4; ++jj) { const bool lo = (j0 + jj) < t, le = (j0 + jj) <= t; l4[jj] = lo ? -mab[jj] : 0.f; m4[jj] = lo ? mak[jj] : 0.f; b4[jj] = le ? nrb[jj] : 0.f; k4[jj] = le ? nrk[jj] : 0.f; }
            *(LAS f32x4*)(Lf + t * 68 + j0) = (f32x4){l4[0], l4[1], l4[2], l4[3]};
            *(LAS u32x2_t*)(MAK + t * 72 + j0) = (u32x2_t){pk2(m4[0], m4[1]), pk2(m4[2], m4[3])};
            *(LAS u32x2_t*)(NRB + t * 72 + j0) = (u32x2_t){pk2(b4[0], b4[1]), pk2(b4[2], b4[3])};
            *(LAS u32x2_t*)(NRK + t * 72 + j0) = (u32x2_t){pk2(k4[0], k4[1]), pk2(k4[2], k4[3])}; } }
        LDS_BARRIER();
        { const int tt = wave >> 1;
#pragma unroll
          for (int q = 0; q < 2; ++q) { const int vt = (wave & 1) * 2 + q; f32x4 acc = (f32x4){0.f, 0.f, 0.f, 0.f};
#pragma unroll
            for (int kk = 0; kk < 2; ++kk) acc = __builtin_amdgcn_mfma_f32_16x16x32_bf16(*(const LAS bf16x8_t*)(MAK + (tt * 16 + fr) * 72 + kk * 32 + 8 * fq), *(const LAS bf16x8_t*)(VTT + (vt * 16 + fr) * 72 + kk * 32 + 8 * fq), acc, 0, 0, 0);
            *(LAS f32x4*)(RHSUT + (vt * 16 + fr) * 68 + tt * 16 + 4 * fq) = acc; } }
        LDS_BARRIER();
        f32x2 us2[32];
        if (tid < 64) {
#pragma unroll
            for (int m = 0; m < 16; ++m) { const f32x4 r4 = *(const LAS f32x4*)(RHSUT + tid * 68 + 4 * m); us2[2 * m] = (f32x2){r4.x, r4.y}; us2[2 * m + 1] = (f32x2){r4.z, r4.w}; }
        } else if (tid < 128) {
#pragma unroll
            for (int m = 0; m < 32; ++m) us2[m] = (f32x2){bflo((unsigned)AT[(2 * m) * 72 + tid - 64]), bflo((unsigned)AT[(2 * m + 1) * 72 + tid - 64])};
        }
        LDS_BARRIER();
        if (tid < 128) {
            const LAS float* Lfv = Lf; asm volatile("" : "+v"(Lfv));
#pragma unroll
            for (int i = 1; i < 64; ++i) { f32x2 a0 = (f32x2){0.f, 0.f}, a1 = (f32x2){0.f, 0.f}; if (i & 1) __builtin_amdgcn_sched_barrier(0);
#pragma unroll
                for (int j4 = 0; j4 < 16; ++j4) if (4 * j4 < i) { const f32x4 l4 = *(const LAS f32x4*)(Lfv + i * 68 + 4 * j4); a0 += (f32x2){l4.x, l4.y} * us2[2 * j4]; a1 += (f32x2){l4.z, l4.w} * us2[2 * j4 + 1]; }
                const float sub = (a0.x + a0.y) + (a1.x + a1.y);
                if (i & 1) us2[i >> 1].y -= sub; else us2[i >> 1].x -= sub; }
            LAS bf16* dstp = tid < 64 ? U0T + tid * 72 : WTT + (tid - 64) * 72;
#pragma unroll
            for (int m = 0; m < 32; m += 4) *(LAS v4u*)(dstp + 2 * m) = (v4u){pk2(us2[m].x, us2[m].y), pk2(us2[m + 1].x, us2[m + 1].y), pk2(us2[m + 2].x, us2[m + 2].y), pk2(us2[m + 3].x, us2[m + 3].y)};
        }
        LDS_BARRIER();
        { const int rt = wave >> 1, rowl = rt * 16 + fr;
#pragma unroll
          for (int q = 0; q < 2; ++q) { const int ct = (wave & 1) * 2 + q, c0 = ct * 16 + 4 * fq;
            f32x4 a1 = (f32x4){0.f, 0.f, 0.f, 0.f}, a2 = a1, a3 = a1, a4 = a1;
#pragma unroll
            for (int kk = 0; kk < 2; ++kk) { const int ko = kk * 32 + 8 * fq;
                const bf16x8_t wtt_c = *(const LAS bf16x8_t*)(WTT + (ct * 16 + fr) * 72 + ko), u0t_c = *(const LAS bf16x8_t*)(U0T + (ct * 16 + fr) * 72 + ko), vtt_c = *(const LAS bf16x8_t*)(VTT + (ct * 16 + fr) * 72 + ko);
                const bf16x8_t btt_c = *(const LAS bf16x8_t*)(BTT + (ct * 16 + fr) * 72 + ko), ktt_c = *(const LAS bf16x8_t*)(KTT + (ct * 16 + fr) * 72 + ko);
                const bf16x8_t nrb_r = *(const LAS bf16x8_t*)(NRB + rowl * 72 + ko), nrk_r = *(const LAS bf16x8_t*)(NRK + rowl * 72 + ko);
                const bf16x8_t btt_r = *(const LAS bf16x8_t*)(BTT + rowl * 72 + ko), u0t_r = *(const LAS bf16x8_t*)(U0T + rowl * 72 + ko), vtt_r = *(const LAS bf16x8_t*)(VTT + rowl * 72 + ko);
                a1 = __builtin_amdgcn_mfma_f32_16x16x32_bf16(wtt_c, nrb_r, a1, 0, 0, 0);
                a2 = __builtin_amdgcn_mfma_f32_16x16x32_bf16(u0t_c, nrb_r, a2, 0, 0, 0); a2 = __builtin_amdgcn_mfma_f32_16x16x32_bf16(vtt_c, nrk_r, a2, 0, 0, 0);
                a3 = __builtin_amdgcn_mfma_f32_16x16x32_bf16(wtt_c, btt_r, a3, 0, 0, 0);
                a4 = __builtin_amdgcn_mfma_f32_16x16x32_bf16(btt_c, u0t_r, a4, 0, 0, 0); a4 = __builtin_amdgcn_mfma_f32_16x16x32_bf16(ktt_c, vtt_r, a4, 0, 0, 0); }
            const u32x2_t rn = *(const LAS u32x2_t*)(RTn + rowl * 72 + c0);
            a1 += (f32x4){bflo(rn.x), bfhi(rn.x), bflo(rn.y), bfhi(rn.y)};
            *(u32x2_t*)((bf16*)(img + RI_RT) + rowl * 72 + c0) = (u32x2_t){pk2(a1.x, a1.y), pk2(a1.z, a1.w)};
            *(u32x2_t*)(O + (rowb + rowl) * D + 512 + hd * 64 + c0) = (u32x2_t){pk2(a2.x, a2.y), pk2(a2.z, a2.w)};
            a3 = a3 * WCCL[rowl];
            *(u32x2_t*)((bf16*)(img + RI_GP) + rowl * 72 + c0) = (u32x2_t){pk2(a3.x, a3.y), pk2(a3.z, a3.w)};
            a4 = a4 * *(const LAS f32x4*)(WCCL + c0);
            *(u32x2_t*)((bf16*)(img + RI_HAT) + rowl * 72 + c0) = (u32x2_t){pk2(a4.x, a4.y), pk2(a4.z, a4.w)}; } }
        LDS_BARRIER();
    }
#undef RWKVA_PREFETCH
#undef RWKVA_DC
#undef RWKVA_ITEM
}
__device__ __forceinline__ void rwkv_phase_b(LAS unsigned char* lds, int tid_in, int wave_in, int b, int hd, const unsigned char* RS, bf16* O, const float* gn_w, const float* gn_b) {
    LAS bf16* GP = (LAS bf16*)(lds + RI_GP); LAS bf16* HAT = (LAS bf16*)(lds + RI_HAT); LAS bf16* RT = (LAS bf16*)(lds + RI_RT); LAS bf16* RKV = (LAS bf16*)(lds + RI_RKV); LAS bf16* GG = (LAS bf16*)(lds + RI_GG);
    LAS float* WCC = (LAS float*)(lds + RI_WCC); LAS bf16* HT = (LAS bf16*)(lds + 44288); LAS float* YS = (LAS float*)(lds + 53504);
    f32x4 Hacc[2];
    Hacc[0] = (f32x4){0.f, 0.f, 0.f, 0.f}; Hacc[1] = Hacc[0];
    for (int e = tid_in; e < 64 * 72 / 2; e += NT) ((LAS unsigned*)HT)[e] = 0u;
    const float gnw = gn_w[hd * 64 + (tid_in & 63)], gnb = gn_b[hd * 64 + (tid_in & 63)];
    const size_t rowb = (size_t)b * SEQ;
    const unsigned char* rsb = RS + (size_t)((b * 8 + hd) * 32) * RI_BYTES;
    v4u ring[4][6]; u32x2_t yring[4][2];
#define RWKVB_PREFETCH(cn, st) do { const v4u* src_ = (const v4u*)(rsb + (size_t)(cn) * RI_BYTES); _Pragma("unroll") for (int k = 0; k < 6; ++k) { const int e = tid_in + k * NT; if (e < RI_BYTES / 16) ring[st][k] = src_[e]; } \
        { const int l_ = tid_in & 63, w_ = tid_in >> 6; _Pragma("unroll") for (int q = 0; q < 2; ++q) yring[st][q] = *(const u32x2_t*)(O + (rowb + (cn) * 64 + (w_ >> 1) * 16 + (l_ & 15)) * D + 512 + hd * 64 + ((w_ & 1) * 2 + q) * 16 + 4 * (l_ >> 4)); } } while (0)
    RWKVB_PREFETCH(0, 0); RWKVB_PREFETCH(1, 1); RWKVB_PREFETCH(2, 2); RWKVB_PREFETCH(3, 3);
    LDS_BARRIER();
    for (int c0 = 0; c0 < SEQ / 64; c0 += 4) {
#pragma unroll
      for (int st = 0; st < 4; ++st) { const int c = c0 + st;
        int tid_l = tid_in, wave_l = wave_in; asm volatile("" : "+v"(tid_l), "+s"(wave_l));
        const int tid = tid_l, wave = wave_l, lane = tid & 63, fr = lane & 15, fq = lane >> 4;
#pragma unroll
        for (int k = 0; k < 6; ++k) { const int e = tid + k * NT; if (e < RI_BYTES / 16) *(LAS v4u*)(lds + e * 16) = ring[st][k]; }
        const u32x2_t yc0 = yring[st][0], yc1 = yring[st][1];
        if (c + 4 < SEQ / 64) RWKVB_PREFETCH(c + 4, st);
        LDS_BARRIER();
        { const int tt = wave >> 1;
#pragma unroll
          for (int q = 0; q < 2; ++q) { const int vt = (wave & 1) * 2 + q; f32x4 acc = (f32x4){0.f, 0.f, 0.f, 0.f};
#pragma unroll
            for (int kk = 0; kk < 2; ++kk) acc = __builtin_amdgcn_mfma_f32_16x16x32_bf16(*(const LAS bf16x8_t*)(HT + (vt * 16 + fr) * 72 + kk * 32 + 8 * fq), *(const LAS bf16x8_t*)(RT + (tt * 16 + fr) * 72 + kk * 32 + 8 * fq), acc, 0, 0, 0);
            const u32x2_t yy = q ? yc1 : yc0;
            acc += (f32x4){bflo(yy.x), bfhi(yy.x), bflo(yy.y), bfhi(yy.y)};
            *(LAS f32x4*)(YS + (tt * 16 + fr) * 68 + vt * 16 + 4 * fq) = acc; }
          const int kt = wave >> 1; const f32x4 wc4 = *(const LAS f32x4*)(WCC + kt * 16 + 4 * fq);
#pragma unroll
          for (int q = 0; q < 2; ++q) { const int vt = (wave & 1) * 2 + q; f32x4 acc = Hacc[q] * wc4;
#pragma unroll
            for (int kk = 0; kk < 2; ++kk) acc = __builtin_amdgcn_mfma_f32_16x16x32_bf16(*(const LAS bf16x8_t*)(GP + (kt * 16 + fr) * 72 + kk * 32 + 8 * fq), *(const LAS bf16x8_t*)(HT + (vt * 16 + fr) * 72 + kk * 32 + 8 * fq), acc, 0, 0, 0);
            const u32x2_t ha = *(const LAS u32x2_t*)(HAT + (vt * 16 + fr) * 72 + kt * 16 + 4 * fq);
            Hacc[q] = acc + (f32x4){bflo(ha.x), bfhi(ha.x), bflo(ha.y), bfhi(ha.y)}; } }
        LDS_BARRIER();
        { const int kt = wave >> 1;
#pragma unroll
          for (int q = 0; q < 2; ++q) { const int vt = (wave & 1) * 2 + q; *(LAS u32x2_t*)(HT + (vt * 16 + fr) * 72 + kt * 16 + 4 * fq) = (u32x2_t){pk2(Hacc[q].x, Hacc[q].y), pk2(Hacc[q].z, Hacc[q].w)}; } }
#pragma unroll
        for (int i = 0; i < 8; ++i) { const int t = wave * 8 + i; const float y = YS[t * 68 + lane];
            const float mean = wave_sum(y) * (1.f / 64.f), d = y - mean, var = wave_sum(d * d) * (1.f / 64.f);
            const float yn = d * frsq(var + 64e-5f) * gnw + gnb;
            O[(rowb + c * 64 + t) * D + 512 + hd * 64 + lane] = (bf16)f2bf((yn + bflo((unsigned)RKV[t * 64 + lane])) * bflo((unsigned)GG[t * 64 + lane])); }
        LDS_BARRIER();
      }
    }
#undef RWKVB_PREFETCH
}
#ifndef REP_EVEN
#define REP_EVEN 1
#endif
#ifndef REP_ODD
#define REP_ODD 1
#endif
#ifndef REP_GLA2
#define REP_GLA2 1
#endif
#ifndef REP_SSD2
#define REP_SSD2 1
#endif
#ifndef ODD2_UNITS
#define ODD2_UNITS 256
#endif
#ifndef REP_GEMM
#define REP_GEMM 1
#endif
#ifndef REP_EVENB
#define REP_EVENB 1
#endif
#ifndef REP_MASK
#define REP_MASK 3
#endif
struct Args { const float* in[34]; float* out; unsigned char* ws; int lo, hi; };
__global__ void __launch_bounds__(NT, 2) trunk_fwd(Args args) {
    extern __shared__ __attribute__((aligned(16))) unsigned char lds_raw[];
    LAS unsigned char* lds = (LAS unsigned char*)lds_raw;
    const int G = gridDim.x, bx = blockIdx.x, NGW = G * NWAVES, NGT = G * NT;
#define KARGS() const __attribute__((address_space(4))) Args* KA = (const __attribute__((address_space(4))) Args*)__builtin_amdgcn_kernarg_segment_ptr(); asm volatile("" : "+s"(KA))
#define FRESH() KARGS(); int tid = threadIdx.x; asm volatile("" : "+v"(tid)); const int lane = tid & 63, wave = __builtin_amdgcn_readfirstlane(tid >> 6); const int gw = bx * NWAVES + wave, gt = bx * NT + tid; (void)gt; (void)gw; (void)lane
    unsigned char* ws = args.ws;
    bf16* XN = (bf16*)(ws + WS_XN); float* SMALL = (float*)(ws + WS_SMALL); bf16* PROJ = (bf16*)(ws + WS_PROJ); bf16* HB = PROJ;
    float* out = args.out; bf16* HN = (bf16*)out; float* SSQ = (float*)(ws + WS_SSQ); float* HF = (float*)(ws + WS_HF);
    const int lo = args.lo, hi = args.hi;
    int ph = 0;
#if MK_COOP
    cg::grid_group grid = cg::this_grid();
    volatile LAS unsigned* MISC = (volatile LAS unsigned*)(lds + MISC_OFF);
    if (threadIdx.x < 64) MISC[threadIdx.x] = 0u;
    __syncthreads();
    const XcdBarrier xbar = xcd_barrier_post((unsigned*)(ws + WS_CTL) + CW_BAR, MISC + 8);
#define SEAM() do { xcd_barrier(xbar); } while (0)
    if (args.lo == 0x7fffffff) grid.sync();
#define IN_PHASE (true)
#else
#define SEAM() do { ++ph; } while (0)
#define IN_PHASE (ph >= lo && ph < hi)
#endif

    if (IN_PHASE) {
        FRESH();
        LAS float* scr = (LAS float*)(lds + wave * 16384);
#pragma unroll 1
        for (int L = 0; L < DEPTH; ++L) {
            const int i = L >> 1; unsigned char* wl = ws + WS_W + (size_t)L * W_LAYER;
            if ((L & 1) == 0) { const float* W = KA->in[6] + (size_t)i * D * EVEN_IN;
                transpose_matrix(W, EVEN_IN, D, (bf16*)(wl + W_IN), PE, 2048, scr, gw, NGW, lane, KA->in[1] + L * D); tail_rows(W, EVEN_IN, (bf16*)(wl + W_IN), PE, NE, true, gt, NGT, KA->in[1] + L * D);
                transpose_matrix(KA->in[14] + (size_t)i * D * D, D, D, (bf16*)(wl + W_OUT), D, 1 << 30, scr, gw, NGW, lane, nullptr);
            } else { const float* W = KA->in[15] + (size_t)i * D * ODD_IN;
                transpose_matrix(W, ODD_IN, D, (bf16*)(wl + W_IN), PO, 1536, scr, gw, NGW, lane, KA->in[1] + L * D); tail_rows(W, ODD_IN, (bf16*)(wl + W_IN), PO, NO, false, gt, NGT, KA->in[1] + L * D);
                transpose_matrix(KA->in[33] + (size_t)i * D * D, D, D, (bf16*)(wl + W_OUT), D, 1 << 30, scr, gw, NGW, lane, nullptr);
            }
        }
        copy_rows_bf16_ssq(KA->in[0], HN, SSQ, gw, NGW, lane);
    }
    SEAM();
#pragma unroll 1
    for (int L = 0; L < DEPTH; ++L) {
        const int i = L >> 1; const bool even = (L & 1) == 0;
        unsigned char* wl = ws + WS_W + (size_t)L * W_LAYER;
        if (IN_PHASE) {
            const int Np = even ? NE : NO;
            pg8::Gemm g{HN, (const bf16*)(wl + W_IN), M, Np, D}; pg8::StaticOrder S; S.init(M, Np, G, bx);
            pg8::EpiProj E{PROJ, even ? PE : PO, (even ? PE : PO) / 256, SMALL, SSQ, (LAS float*)(lds + RSTD_OFF)};
            for (int rg = 0; rg < REP_GEMM; ++rg) pg8::gemm_phase<pg8::EpiProj, pg8::StaticOrder, true, true>(lds, g, S, E);
        }
        SEAM();
        if (IN_PHASE) {
            FRESH();
#ifndef NO_EVEN
            if (even) {
                for (int rep = 0; rep < REP_EVEN; ++rep) {
                int tl = tid; asm volatile("" : "+v"(tl)); const int ll = tl & 63;
                if (rep == 0 || (REP_MASK & 1)) gdn_phase_a(lds, tl, wave, bx, G, PROJ, SMALL, ws + WS_GS, KA->in[7] + (size_t)i * 4 * 1536, KA->in[8] + i * 4, KA->in[9] + i * 4);
                }
            }
#endif
#ifndef NO_ODD
            if (!even) {
                RwkvW W{KA->in[22] + i * 1792, KA->in[23] + i * 512, KA->in[24] + (size_t)i * 64 * 512, KA->in[25] + i * 512, KA->in[26] + (size_t)i * 64 * 512, KA->in[27] + (size_t)i * 128 * 512,
                        KA->in[28] + i * 512, KA->in[29] + i * 512, KA->in[30] + i * 512, KA->in[31] + i * 512, KA->in[32] + i * 512};
                for (int rep = 0; rep < REP_ODD; ++rep) { int tl = tid; asm volatile("" : "+v"(tl)); rwkv_phase_a(lds, tl, wave, bx, G, PROJ, XN, ws + WS_RS, W); }
            }
#endif
        }
        SEAM();
        if (even) { if (IN_PHASE) { FRESH(); for (int rep = 0; rep < REP_EVENB; ++rep) { int tl = tid; asm volatile("" : "+v"(tl)); if (bx < 64) gdn_phase_b(lds, tl, wave, bx >> 2, bx & 3, PROJ, ws + WS_GS, XN, KA->in[10] + i * 128);
                else if (bx < 128) for (int rg2 = 0; rg2 < REP_GLA2; ++rg2) gla_chunked(lds, tl, wave, (bx - 64) >> 2, bx & 3, PROJ, SMALL, XN, KA->in[11] + (size_t)i * 16 * 256, KA->in[12] + i * 256, KA->in[13] + i * 128);
                else if (rep == 0) { LAS float* scr = (LAS float*)(lds + wave * 16384); transpose_matrix(KA->in[3] + (size_t)L * D * FF, FF, D, (bf16*)(ws + WS_WMLP + W_1), FF, 1 << 30, scr, ((bx - 128) * NWAVES + wave), ((G - 128) * NWAVES), lane, KA->in[2] + L * D); transpose_matrix(KA->in[4] + (size_t)L * FF * D, D, FF, (bf16*)(ws + WS_WMLP + W_2), D, 1 << 30, scr, ((bx - 128) * NWAVES + wave), ((G - 128) * NWAVES), lane, nullptr); } } } SEAM(); }
        if (!even) { if (IN_PHASE) { FRESH();
            for (int uu = bx; uu < ODD2_UNITS; uu += G) { const int u = uu & 255; const int b = (u & 127) >> 3, hd = u & 7; int tl = tid; asm volatile("" : "+v"(tl));
                if (u < 128) for (int rs2 = 0; rs2 < REP_SSD2; ++rs2) ssd_chunked(lds, tl, wave, b, hd, PROJ, SMALL, XN, KA->in[16] + (size_t)i * 4 * 1024, KA->in[17] + i * 1024, KA->in[18][i * 8 + hd], KA->in[19][i * 8 + hd], KA->in[20][i * 8 + hd]);
                else rwkv_phase_b(lds, tl, wave, b, hd, ws + WS_RS, XN, KA->in[31] + i * 512, KA->in[32] + i * 512); }
            if (bx < 128) { LAS float* scr = (LAS float*)(lds + wave * 16384); transpose_matrix(KA->in[3] + (size_t)L * D * FF, FF, D, (bf16*)(ws + WS_WMLP + W_1), FF, 1 << 30, scr, (bx * NWAVES + wave), (128 * NWAVES), lane, KA->in[2] + L * D); transpose_matrix(KA->in[4] + (size_t)L * FF * D, D, FF, (bf16*)(ws + WS_WMLP + W_2), D, 1 << 30, scr, (bx * NWAVES + wave), (128 * NWAVES), lane, nullptr); }
        } SEAM(); }
        if (!even) { if (IN_PHASE) { FRESH(); ssd_fix(XN, KA->in[21] + i * 512, gw, NGW, lane); } SEAM(); }
        if (IN_PHASE) {
            KARGS();
            pg8::Gemm g{XN, (const bf16*)(wl + W_OUT), M, D, D}; pg8::StaticOrder S; S.init(M, D, G, bx);
            pg8::EpiRes E{nullptr, D, HN, SSQ};
            pg8::gemm_phase<pg8::EpiRes, pg8::StaticOrder, true, true>(lds, g, S, E);
        }
        SEAM();
        if (IN_PHASE) {
            pg8::Gemm g{HN, (const bf16*)(ws + WS_WMLP + W_1), M, FF, D}; pg8::StaticOrder S; S.init(M, FF, G, bx);
            pg8::EpiSq E{HB, FF, SSQ, (LAS float*)(lds + RSTD_OFF)};
            for (int rg = 0; rg < REP_GEMM; ++rg) pg8::gemm_phase<pg8::EpiSq, pg8::StaticOrder, true, true>(lds, g, S, E);
        }
        SEAM();
        if (IN_PHASE) {
            pg8::Gemm g{HB, (const bf16*)(ws + WS_WMLP + W_2), M, D, FF}; pg8::StaticOrder S; S.init(M, D, G, bx);
            pg8::EpiRes E{L + 1 == DEPTH ? HF : nullptr, D, HN, SSQ};
            pg8::gemm_phase<pg8::EpiRes, pg8::StaticOrder, true, true>(lds, g, S, E);
        }
        SEAM();
        if (L + 1 == DEPTH) { if (IN_PHASE) { FRESH(); norm_rows_f32(HF, out, KA->in[5], gw, NGW, lane); } }
    }
#undef SEAM
#undef IN_PHASE
}
constexpr int N_PHASES = 1 + DEPTH * 8;

extern "C" void kernel_launch(void* const* d_in, const int* in_sizes, int n_in, void* d_out, int out_size, void* d_ws, size_t ws_size, hipStream_t stream) {
    static int grid = 0;
    if (grid == 0) {
        if (n_in != 34 || in_sizes[0] != M * D || out_size != M * D || ws_size < WS_END) { fprintf(stderr, "kernel_launch: unexpected shapes (n_in %d, in0 %d, out %d, ws %zu); nothing launched\n", n_in, n_in > 0 ? in_sizes[0] : -1, out_size, ws_size); grid = -1; return; }
        int dev = 0, cus = 0, per_cu = 0;
        if (hipGetDevice(&dev) != hipSuccess || hipDeviceGetAttribute(&cus, hipDeviceAttributeMultiprocessorCount, dev) != hipSuccess) { grid = -1; return; }
        if (hipFuncSetAttribute((const void*)trunk_fwd, hipFuncAttributeMaxDynamicSharedMemorySize, LDS_BYTES) != hipSuccess) { fprintf(stderr, "kernel_launch: hipFuncSetAttribute failed\n"); grid = -1; return; }
        if (hipOccupancyMaxActiveBlocksPerMultiprocessor(&per_cu, (const void*)trunk_fwd, NT, LDS_BYTES) != hipSuccess || per_cu < 1) { fprintf(stderr, "kernel_launch: occupancy query says %d\n", per_cu); per_cu = 1; }
        (void)hipGetLastError();
        grid = cus * 1;
    }
    if (grid < 0) return;
    if (hipMemsetAsync((char*)d_ws + WS_CTL, 0, CTL_ZERO_BYTES, stream) != hipSuccess) { fprintf(stderr, "kernel_launch: memset failed\n"); return; }
    Args a{};
    for (int i = 0; i < 34; ++i) a.in[i] = (const float*)d_in[i];
    a.out = (float*)d_out; a.ws = (unsigned char*)d_ws;
#if MK_COOP
    a.lo = 0; a.hi = N_PHASES;
    void* kargs[] = {&a};
    hipError_t e = hipLaunchCooperativeKernel((const void*)trunk_fwd, dim3(grid), dim3(NT), kargs, LDS_BYTES, stream);
    if (e != hipSuccess) fprintf(stderr, "kernel_launch: cooperative launch failed: %s (grid %d)\n", hipGetErrorString(e), grid);
#else
    for (int p = 0; p < N_PHASES; ++p) { a.lo = p; a.hi = p + 1; hipLaunchKernelGGL(trunk_fwd, dim3(grid), dim3(NT), LDS_BYTES, stream, a); }
#endif
}
```
